# Optimizing an MI355X kernel written in HIP

```python
import math
import jax, jax.numpy as jnp
from jax import lax
import numpy as np

D_MODEL = 1024
BATCH = 1
SEQ = 16384
DEPTH = 2
DEC_BATCH = 32
DEC_SEQ = 16
PAST_LEN = 2048

CHUNK = 64
Q_BLOCK = 128
CONV_A_CH = 512
CONV_A_WIDTH = 31
GDN_HEADS = 4
GDN_DK = 128
GDN_DV = 128
GDN_CONV_WIDTH = 4
GDN_QKV_WIDTH = 2 * GDN_HEADS * GDN_DK + GDN_HEADS * GDN_DV
MLA_HEADS = 4
MLA_Q_LORA = 384
MLA_KV_LORA = 256
MLA_NOPE_DIM = 128
MLA_ROPE_DIM = 64
MLA_V_DIM = 128
ROPE_THETA = 10000.0
N_BRANCH = 3
BRANCH_WIDTH = 512
D_FF = 2816
FFN_CONV_WIDTH = 3
DN_ALPHA = (2 * DEPTH) ** 0.25
DN_BETA = (8 * DEPTH) ** -0.25
LN_EPS = 1e-5
RMS_EPS = 1e-6

IN_SIZES = (
    2 * CONV_A_CH,
    GDN_QKV_WIDTH,
    GDN_HEADS * GDN_DV,
    GDN_HEADS,
    GDN_HEADS,
    MLA_Q_LORA,
    MLA_KV_LORA,
    MLA_ROPE_DIM,
    N_BRANCH * D_MODEL,
)
IN_WIDTH = sum(IN_SIZES)

kernel_name = 'hybrid_streaming_encoder_step'


def split_columns(z, sizes):
    offsets = np.cumsum(np.array(sizes))[:-1].tolist()
    return jnp.split(z, offsets, axis=-1)


def layer_norm(x, g, b):
    xf = x.astype(jnp.float32)
    mu = jnp.mean(xf, axis=-1, keepdims=True)
    var = jnp.mean(jnp.square(xf - mu), axis=-1, keepdims=True)
    return ((xf - mu) * lax.rsqrt(var + LN_EPS) * g.astype(jnp.float32) + b.astype(jnp.float32)).astype(x.dtype)


def rms_norm(x, g):
    xf = x.astype(jnp.float32)
    return (xf * lax.rsqrt(jnp.mean(xf * xf, axis=-1, keepdims=True) + RMS_EPS) * g.astype(jnp.float32)).astype(x.dtype)


def l2_normalize(x):
    return x * lax.rsqrt(jnp.sum(x * x, axis=-1, keepdims=True) + RMS_EPS)


def causal_dwconv(x, hist, w):
    k = w.shape[0]
    xp = jnp.concatenate([hist.astype(x.dtype), x], axis=1)
    y = lax.conv_general_dilated(xp, w[:, None, :].astype(x.dtype), window_strides=(1,), padding='VALID',
                                 dimension_numbers=('NWC', 'WIO', 'NWC'), feature_group_count=x.shape[-1])
    return y, xp[:, xp.shape[1] - (k - 1):]


def rope_tables(pos):
    half = MLA_ROPE_DIM // 2
    inv_freq = ROPE_THETA ** (-jnp.arange(half, dtype=jnp.float32) / half)
    ang = pos.astype(jnp.float32)[:, None] * inv_freq[None, :]
    return jnp.cos(ang), jnp.sin(ang)


def apply_rope(x, cos, sin):
    x1, x2 = jnp.split(x.astype(jnp.float32), 2, axis=-1)
    return jnp.concatenate([x1 * cos - x2 * sin, x2 * cos + x1 * sin], axis=-1).astype(x.dtype)


def chunk_attention(q, k, v, q_pos, k_pos):
    b, tq, h, dq = q.shape
    dv = v.shape[-1]
    scale = dq ** -0.5
    k_chunk = k_pos // CHUNK

    def attend(qb, qp):
        s = jnp.einsum('bqhd,bkhd->bhqk', qb, k, preferred_element_type=jnp.float32) * scale
        mask = k_chunk[None, :] <= (qp // CHUNK)[:, None]
        p = jax.nn.softmax(jnp.where(mask, s, -jnp.inf), axis=-1)
        return jnp.einsum('bhqk,bkhd->bqhd', p.astype(v.dtype), v)

    if tq > Q_BLOCK and tq % Q_BLOCK == 0:
        nb = tq // Q_BLOCK
        qb = jnp.moveaxis(q.reshape(b, nb, Q_BLOCK, h, dq), 1, 0)
        qp = q_pos.reshape(nb, Q_BLOCK)
        o = lax.map(lambda a: attend(a[0], a[1]), (qb, qp))
        return jnp.moveaxis(o, 0, 1).reshape(b, tq, h, dv)
    return attend(q, q_pos)


def gated_delta_rule(q, k, v, g, beta, state):
    b, t, h, dk = q.shape
    dv = v.shape[-1]
    c = min(CHUNK, t)
    n = t // c

    def chunks(a):
        return jnp.moveaxis(a.reshape((b, n, c, h) + a.shape[3:]), (1, 3), (0, 2))

    q, k, v, g, beta = chunks(q), chunks(k), chunks(v), chunks(g), chunks(beta)
    g = jnp.cumsum(g, axis=-1)
    tri = jnp.tril(jnp.ones((c, c), dtype=bool))
    strict = jnp.tril(jnp.ones((c, c), dtype=bool), -1)
    diff = g[..., :, None] - g[..., None, :]
    decay = jnp.where(tri, jnp.exp(jnp.where(tri, diff, 0.0)), 0.0)
    kk = jnp.einsum('nbhid,nbhjd->nbhij', k, k)
    lmat = jnp.where(strict, beta[..., :, None] * kk * decay, 0.0)
    rhs = jnp.concatenate([v * beta[..., None], k * (beta * jnp.exp(g))[..., None]], axis=-1)
    sol = lax.linalg.triangular_solve(jnp.eye(c, dtype=jnp.float32) + lmat, rhs,
                                      left_side=True, lower=True, unit_diagonal=True)
    u, w = sol[..., :dv], sol[..., dv:]
    qk = jnp.where(tri, jnp.einsum('nbhid,nbhjd->nbhij', q, k) * decay, 0.0)
    q_dec = q * jnp.exp(g)[..., None]
    g_last = g[..., -1]
    k_dec = k * jnp.exp(g_last[..., None] - g)[..., None]

    def step(s, xs):
        u_c, w_c, qk_c, qd_c, kd_c, gl_c = xs
        v_new = u_c - jnp.einsum('bhck,bhkv->bhcv', w_c, s)
        o = jnp.einsum('bhck,bhkv->bhcv', qd_c, s) + jnp.einsum('bhij,bhjv->bhiv', qk_c, v_new)
        s = s * jnp.exp(gl_c)[..., None, None] + jnp.einsum('bhck,bhcv->bhkv', kd_c, v_new)
        return s, o

    state, o = lax.scan(step, state, (u, w, qk, q_dec, k_dec, g_last))
    o = jnp.moveaxis(o, (0, 2), (1, 3)).reshape(b, t, h, dv)
    return o, state


def conv_module(pre, hist, w, bias, ln_g, ln_b):
    a, gate = jnp.split(pre, 2, axis=-1)
    u = a * jax.nn.sigmoid(gate)
    y, hist = causal_dwconv(u, hist, w)
    return jax.nn.silu(layer_norm(y + bias, ln_g, ln_b)), hist


def gated_deltanet(qkv, z, beta_pre, dec_pre, hist, state, conv_w, a_log, dt_bias, norm_g):
    b, t, _ = qkv.shape
    qkv, hist = causal_dwconv(qkv, hist, conv_w)
    qkv = jax.nn.silu(qkv.astype(jnp.float32))
    nk = GDN_HEADS * GDN_DK
    q = l2_normalize(qkv[..., :nk].reshape(b, t, GDN_HEADS, GDN_DK)) * (GDN_DK ** -0.5)
    k = l2_normalize(qkv[..., nk:2 * nk].reshape(b, t, GDN_HEADS, GDN_DK))
    v = qkv[..., 2 * nk:].reshape(b, t, GDN_HEADS, GDN_DV)
    beta = jax.nn.sigmoid(beta_pre.astype(jnp.float32))
    g = -jnp.exp(a_log.astype(jnp.float32)) * jax.nn.softplus(dec_pre.astype(jnp.float32) + dt_bias.astype(jnp.float32))
    o, state = gated_delta_rule(q, k, v, g, beta, state.astype(jnp.float32))
    o = rms_norm(o, norm_g) * jax.nn.silu(z.astype(jnp.float32).reshape(b, t, GDN_HEADS, GDN_DV))
    return o.reshape(b, t, GDN_HEADS * GDN_DV), hist, state


def latent_attention(q_lat, kv_lat, k_pe, cache_lat, cache_kpe, q_norm_g, kv_norm_g, w_uq, w_ukv):
    b, t, _ = q_lat.shape
    past = cache_lat.shape[1]
    tk = past + t
    q_pos = past + jnp.arange(t, dtype=jnp.int32)
    k_pos = jnp.arange(tk, dtype=jnp.int32)
    cos, sin = rope_tables(q_pos)
    q = (rms_norm(q_lat, q_norm_g) @ w_uq).reshape(b, t, MLA_HEADS, MLA_NOPE_DIM + MLA_ROPE_DIM)
    q = jnp.concatenate([q[..., :MLA_NOPE_DIM],
                         apply_rope(q[..., MLA_NOPE_DIM:], cos[:, None, :], sin[:, None, :])], axis=-1)
    lat_new = rms_norm(kv_lat, kv_norm_g)
    kpe_new = apply_rope(k_pe, cos, sin)
    lat_all = jnp.concatenate([cache_lat.astype(lat_new.dtype), lat_new], axis=1)
    kpe_all = jnp.concatenate([cache_kpe.astype(kpe_new.dtype), kpe_new], axis=1)
    kv = (lat_all @ w_ukv).reshape(b, tk, MLA_HEADS, MLA_NOPE_DIM + MLA_V_DIM)
    k = jnp.concatenate([kv[..., :MLA_NOPE_DIM],
                         jnp.broadcast_to(kpe_all[:, :, None, :], (b, tk, MLA_HEADS, MLA_ROPE_DIM))], axis=-1)
    o = chunk_attention(q, k.astype(q.dtype), kv[..., MLA_NOPE_DIM:], q_pos, k_pos)
    return o.reshape(b, t, MLA_HEADS * MLA_V_DIM), lat_new, kpe_new


def run_layer(x, c, cache_lat, cache_kpe, hist_a, hist_b, state_b, hist_f, p):
    b, t, _ = x.shape
    mod = jax.nn.silu(c) @ p['w_ada'] + p['b_ada']
    sh1, sc1, g1, sh2, sc2, g2 = jnp.split(mod[:, None, :], 6, axis=-1)
    h = x * (1 + sc1) + sh1
    (pre_a, qkv_b, z_b, beta_b, dec_b, q_lat, kv_lat, k_pe, gate_pre) = split_columns(h @ p['w_in'], IN_SIZES)
    y_a, hist_a = conv_module(pre_a, hist_a, p['conv_a_w'], p['conv_a_b'], p['ln_a_g'], p['ln_a_b'])
    y_b, hist_b, state_b = gated_deltanet(qkv_b, z_b, beta_b, dec_b, hist_b, state_b, p['gdn_conv_w'],
                                          p['gdn_a_log'], p['gdn_dt_bias'], p['gdn_norm_g'])
    y_c, lat_new, kpe_new = latent_attention(q_lat, kv_lat, k_pe, cache_lat, cache_kpe, p['mla_q_norm_g'],
                                             p['mla_kv_norm_g'], p['mla_w_uq'], p['mla_w_ukv'])
    branches = jnp.stack([y_a.astype(x.dtype), y_b.astype(x.dtype), y_c.astype(x.dtype)], axis=0)
    proj = jnp.einsum('nbtc,ncd->btnd', branches, p['w_branch'])
    gates = jax.nn.sigmoid(gate_pre.astype(jnp.float32)).reshape(b, t, N_BRANCH, D_MODEL)
    merged = jnp.sum(gates * proj, axis=2).astype(x.dtype)
    x = layer_norm(DN_ALPHA * x + (1 + g1) * (merged @ p['w_out']), p['ln1_g'], p['ln1_b'])
    h = x * (1 + sc2) + sh2
    a, v = jnp.split(h @ p['w_up'], 2, axis=-1)
    a, hist_f = causal_dwconv(a, hist_f, p['ffn_conv_w'])
    y = (jax.nn.silu(a + p['ffn_conv_b']) * v) @ p['w_down']
    x = layer_norm(DN_ALPHA * x + (1 + g2) * y, p['ln2_g'], p['ln2_b'])
    return x, (lat_new, kpe_new, hist_a, hist_b, state_b, hist_f)


def setup_inputs(seed: int = 0) -> dict:
    key = jax.random.key(seed)
    ks = iter(jax.random.split(key, 64))

    def nrm(shape, scale):
        return scale * jax.random.normal(next(ks), shape, jnp.float32)

    def gain(shape):
        return 1.0 + nrm(shape, 0.02)

    log_dt = jax.random.uniform(next(ks), (DEPTH, GDN_HEADS), jnp.float32, math.log(1e-3), math.log(1e-1))
    dt = jnp.exp(log_dt)
    a_init = jax.random.uniform(next(ks), (DEPTH, GDN_HEADS), jnp.float32, 1.0, 16.0)
    return {
        'x_prompt': nrm((BATCH, SEQ, D_MODEL), 1.0),
        'x_sample': nrm((DEC_BATCH, DEC_SEQ, D_MODEL), 1.0),
        'cache_mla_latent': nrm((DEPTH, DEC_BATCH, PAST_LEN, MLA_KV_LORA), 1.0),
        'cache_mla_kpe': nrm((DEPTH, DEC_BATCH, PAST_LEN, MLA_ROPE_DIM), 1.0),
        'state_conv_a': nrm((DEPTH, DEC_BATCH, CONV_A_WIDTH - 1, CONV_A_CH), 0.5),
        'state_gdn_conv': nrm((DEPTH, DEC_BATCH, GDN_CONV_WIDTH - 1, GDN_QKV_WIDTH), 1.0),
        'state_gdn': nrm((DEPTH, DEC_BATCH, GDN_HEADS, GDN_DK, GDN_DV), 0.1),
        'state_ffn_conv': nrm((DEPTH, DEC_BATCH, FFN_CONV_WIDTH - 1, D_FF), 1.0),
        'c_prompt': nrm((BATCH, D_MODEL), 1.0),
        'c_sample': nrm((DEC_BATCH, D_MODEL), 1.0),
        'ln0_g': gain((D_MODEL,)),
        'ln0_b': nrm((D_MODEL,), 0.02),
        'w_ada': nrm((DEPTH, D_MODEL, 6 * D_MODEL), 0.2 * D_MODEL ** -0.5),
        'b_ada': nrm((DEPTH, 6 * D_MODEL), 0.01),
        'w_in': nrm((DEPTH, D_MODEL, IN_WIDTH), D_MODEL ** -0.5),
        'conv_a_w': nrm((DEPTH, CONV_A_WIDTH, CONV_A_CH), CONV_A_WIDTH ** -0.5),
        'conv_a_b': nrm((DEPTH, CONV_A_CH), 0.02),
        'ln_a_g': gain((DEPTH, CONV_A_CH)),
        'ln_a_b': nrm((DEPTH, CONV_A_CH), 0.02),
        'gdn_conv_w': nrm((DEPTH, GDN_CONV_WIDTH, GDN_QKV_WIDTH), GDN_CONV_WIDTH ** -0.5),
        'gdn_a_log': jnp.log(a_init),
        'gdn_dt_bias': dt + jnp.log(-jnp.expm1(-dt)),
        'gdn_norm_g': gain((DEPTH, GDN_DV)),
        'mla_q_norm_g': gain((DEPTH, MLA_Q_LORA)),
        'mla_kv_norm_g': gain((DEPTH, MLA_KV_LORA)),
        'mla_w_uq': nrm((DEPTH, MLA_Q_LORA, MLA_HEADS * (MLA_NOPE_DIM + MLA_ROPE_DIM)), MLA_Q_LORA ** -0.5),
        'mla_w_ukv': nrm((DEPTH, MLA_KV_LORA, MLA_HEADS * (MLA_NOPE_DIM + MLA_V_DIM)), MLA_KV_LORA ** -0.5),
        'w_branch': nrm((DEPTH, N_BRANCH, BRANCH_WIDTH, D_MODEL), BRANCH_WIDTH ** -0.5),
        'w_out': nrm((DEPTH, D_MODEL, D_MODEL), DN_BETA * D_MODEL ** -0.5),
        'ln1_g': gain((DEPTH, D_MODEL)),
        'ln1_b': nrm((DEPTH, D_MODEL), 0.02),
        'w_up': nrm((DEPTH, D_MODEL, 2 * D_FF), D_MODEL ** -0.5),
        'ffn_conv_w': nrm((DEPTH, FFN_CONV_WIDTH, D_FF), FFN_CONV_WIDTH ** -0.5),
        'ffn_conv_b': nrm((DEPTH, D_FF), 0.02),
        'w_down': nrm((DEPTH, D_FF, D_MODEL), DN_BETA * D_FF ** -0.5),
        'ln2_g': gain((DEPTH, D_MODEL)),
        'ln2_b': nrm((DEPTH, D_MODEL), 0.02),
    }


def reference(x_prompt, x_sample, cache_mla_latent, cache_mla_kpe, state_conv_a, state_gdn_conv, state_gdn,
              state_ffn_conv, c_prompt, c_sample, ln0_g, ln0_b, w_ada, b_ada, w_in, conv_a_w, conv_a_b,
              ln_a_g, ln_a_b, gdn_conv_w, gdn_a_log, gdn_dt_bias, gdn_norm_g, mla_q_norm_g, mla_kv_norm_g,
              mla_w_uq, mla_w_ukv, w_branch, w_out, ln1_g, ln1_b, w_up, ffn_conv_w, ffn_conv_b, w_down,
              ln2_g, ln2_b):
    def layer_params(l):
        return {'w_ada': w_ada[l], 'b_ada': b_ada[l], 'w_in': w_in[l], 'conv_a_w': conv_a_w[l],
                'conv_a_b': conv_a_b[l], 'ln_a_g': ln_a_g[l], 'ln_a_b': ln_a_b[l], 'gdn_conv_w': gdn_conv_w[l],
                'gdn_a_log': gdn_a_log[l], 'gdn_dt_bias': gdn_dt_bias[l], 'gdn_norm_g': gdn_norm_g[l],
                'mla_q_norm_g': mla_q_norm_g[l], 'mla_kv_norm_g': mla_kv_norm_g[l], 'mla_w_uq': mla_w_uq[l],
                'mla_w_ukv': mla_w_ukv[l], 'w_branch': w_branch[l], 'w_out': w_out[l], 'ln1_g': ln1_g[l],
                'ln1_b': ln1_b[l], 'w_up': w_up[l], 'ffn_conv_w': ffn_conv_w[l], 'ffn_conv_b': ffn_conv_b[l],
                'w_down': w_down[l], 'ln2_g': ln2_g[l], 'ln2_b': ln2_b[l]}

    bp = x_prompt.shape[0]
    dt = x_prompt.dtype
    xp = layer_norm(x_prompt, ln0_g, ln0_b)
    xs = layer_norm(x_sample, ln0_g, ln0_b)
    p_states, s_states = [], []
    for l in range(DEPTH):
        p = layer_params(l)
        xp, st_p = run_layer(xp, c_prompt,
                             jnp.zeros((bp, 0, MLA_KV_LORA), dt), jnp.zeros((bp, 0, MLA_ROPE_DIM), dt),
                             jnp.zeros((bp, CONV_A_WIDTH - 1, CONV_A_CH), dt),
                             jnp.zeros((bp, GDN_CONV_WIDTH - 1, GDN_QKV_WIDTH), dt),
                             jnp.zeros((bp, GDN_HEADS, GDN_DK, GDN_DV), jnp.float32),
                             jnp.zeros((bp, FFN_CONV_WIDTH - 1, D_FF), dt), p)
        xs, st_s = run_layer(xs, c_sample, cache_mla_latent[l], cache_mla_kpe[l], state_conv_a[l],
                             state_gdn_conv[l], state_gdn[l], state_ffn_conv[l], p)
        p_states.append(st_p)
        s_states.append(st_s)
    p_lat, p_kpe, p_conv_a, p_gdn_conv, p_gdn, p_ffn = [jnp.stack(z, axis=0) for z in zip(*p_states)]
    s_lat, s_kpe, s_conv_a, s_gdn_conv, s_gdn, s_ffn = [jnp.stack(z, axis=0) for z in zip(*s_states)]
    return (xp, xs, p_lat, p_kpe, p_conv_a, p_gdn_conv, p_gdn, p_ffn,
            s_lat, s_kpe, s_conv_a, s_gdn_conv, s_gdn, s_ffn)
```

```cpp
#include <hip/hip_runtime.h>
#include <hip/hip_cooperative_groups.h>
#include <cstdio>
namespace cg = cooperative_groups;

#define DI __device__ __forceinline__
#define LAS __attribute__((address_space(3)))
typedef unsigned short bf16_t;
typedef short bf16x8 __attribute__((ext_vector_type(8)));
typedef short s16x4 __attribute__((ext_vector_type(4)));
typedef float f32x4 __attribute__((ext_vector_type(4)));
typedef float f32x16 __attribute__((ext_vector_type(16)));
typedef unsigned u32x4 __attribute__((ext_vector_type(4)));
typedef unsigned u32x2 __attribute__((ext_vector_type(2)));

constexpr int MP = 16384, MS = 512, MT = MP + MS, DM = 1024, NZ1 = 3840, NG = 3072, NIN = NZ1 + NG, DFF = 2816;
constexpr int NITEM_GDN = 1152;
enum { I_XP = 0, I_XS, I_CLAT, I_CKPE, I_SCA, I_SGC, I_SGDN, I_SFFN, I_CP, I_CS, I_LN0G, I_LN0B, I_WADA, I_BADA, I_WIN, I_CAW, I_CAB,
       I_LNAG, I_LNAB, I_GCW, I_ALOG, I_DTB, I_GNG, I_QNG, I_KVNG, I_WUQ, I_WUKV, I_WBR, I_WOUT, I_LN1G, I_LN1B, I_WUP, I_FCW, I_FCB,
       I_WDN, I_LN2G, I_LN2B, N_IN };
constexpr size_t O_YP = 0, O_YS = O_YP + (size_t)MP * DM, O_PLAT = O_YS + (size_t)MS * DM, O_PKPE = O_PLAT + 2ull * MP * 256,
                 O_PCA = O_PKPE + 2ull * MP * 64, O_PGC = O_PCA + 2ull * 30 * 512, O_PGDN = O_PGC + 2ull * 3 * 1536,
                 O_PFFN = O_PGDN + 2ull * 4 * 16384, O_SLAT = O_PFFN + 2ull * 2 * DFF, O_SKPE = O_SLAT + 2ull * 32 * 16 * 256,
                 O_SCA = O_SKPE + 2ull * 32 * 16 * 64, O_SGC = O_SCA + 2ull * 32 * 30 * 512, O_SGDN = O_SGC + 2ull * 32 * 3 * 1536,
                 O_SFFN = O_SGDN + 2ull * 32 * 4 * 16384, O_END = O_SFFN + 2ull * 32 * 2 * DFF;
constexpr size_t al256(size_t x) { return (x + 255) & ~(size_t)255; }
constexpr size_t WS_CTL = 0, WS_CTL_BYTES = 16384, WS_MOD = WS_CTL_BYTES, WS_SC = WS_MOD + 64ull * 12288 * 4, WS_ROPE = WS_SC + 256ull * 1024 * 2,
                 WS_WIN = WS_ROPE + 16384ull * 32 * 8, WS_WUQ = WS_WIN + (size_t)NIN * 1024 * 2, WS_WUK = WS_WUQ + 768ull * 384 * 2,
                 WS_WUV = WS_WUK + 512ull * 256 * 2, WS_WQABS = WS_WUV + 512ull * 256 * 2, WS_WBR = WS_WQABS + 1024ull * 384 * 2,
                 WS_WBRC = WS_WBR + 3ull * 1024 * 512 * 2, WS_WOUT = WS_WBRC + 1024ull * 1024 * 2, WS_WUP = WS_WOUT + 1024ull * 1024 * 2,
                 WS_WDN = WS_WUP + 5632ull * 1024 * 2, WS_AB = WS_WDN + 1024ull * 2816 * 2;
constexpr size_t WS_Z1 = WS_AB, WS_G = WS_Z1 + (size_t)MT * NZ1 * 2, WS_UP = WS_AB, WS_WADA = WS_AB;
constexpr size_t WS_Q = WS_AB, WS_KN = WS_Q + (size_t)MT * 768 * 2, WS_VT = WS_KN + (size_t)MP * 512 * 2, WS_QABS = WS_VT + 512ull * MP * 2,
                 WS_YB = WS_QABS + 512ull * 1024 * 2, WS_YC = WS_YB + (size_t)MT * 512 * 2, WS_OLAT = WS_YC + (size_t)MT * 512 * 2,
                 WS_ABUSED = WS_OLAT + 512ull * 1024 * 2;
static_assert(WS_ABUSED <= WS_G, "region A overflow");
constexpr size_t WS_C = WS_G + (size_t)MT * NG * 2;
constexpr size_t WS_QN = WS_C, WS_LAT = WS_QN + (size_t)MT * 384 * 2, WS_KPE = WS_LAT + (size_t)MT * 256 * 2, WS_YA = WS_KPE + (size_t)MT * 64 * 2,
                 WS_SZ = WS_YA + (size_t)MT * 512 * 2, WS_U = WS_SZ + (size_t)MT * 512 * 2, WS_W = WS_U + (size_t)NITEM_GDN * 64 * 128 * 2,
                 WS_QD = WS_W + (size_t)NITEM_GDN * 64 * 128 * 2, WS_KDT = WS_QD + (size_t)NITEM_GDN * 64 * 128 * 2,
                 WS_QK = WS_KDT + (size_t)NITEM_GDN * 64 * 128 * 2, WS_EGL = WS_QK + (size_t)NITEM_GDN * 64 * 64 * 2, WS_CEND = WS_EGL + 8192;
constexpr size_t WS_H = WS_YA, WS_ACT = WS_C, WS_MG = WS_U;
constexpr size_t WS_SNP = WS_ABUSED, WS_SNS = WS_QN;
static_assert(WS_SNP + 1024ull * 32768 <= WS_G, "Sn prompt overflow");
static_assert(128ull * 32768 <= (size_t)MT * 384 * 2, "Sn sample overflow");
static_assert((size_t)MT * DFF * 2 <= WS_CEND - WS_C, "ACT overflow");
static_assert((size_t)MT * 5632 * 2 <= WS_C - WS_AB, "UP overflow");
constexpr int LTS = 2112;
constexpr size_t WS_LATT = WS_CEND, WS_XTRA = WS_LATT + 32ull * 256 * LTS * 2, WS_END = WS_XTRA + 72ull * 1024 * 1024;
constexpr size_t WS_XA = WS_XTRA, WS_XA256 = WS_XA + 512ull * 32768, WS_XS128 = WS_XA256 + 4ull * 32768;
constexpr size_t WS_XB = WS_XS128 + 4ull * 32768;
static_assert(WS_XB + (size_t)MT * 1024 * 2 <= WS_END, "XB overflow");
constexpr int LDS_BYTES = 160 * 1024;
constexpr int LDS_MISC = LDS_BYTES - 256;
constexpr int NSUB = 12;
constexpr int NPHASE = 3 + NSUB * 2;
constexpr float DN_ALPHA = 1.4142135623730951f;

#ifndef PROBE_DUP
#define PROBE_DUP (-1)
#endif
struct Ctx { const float* in[N_IN]; float* out; unsigned char* ws; int ph_lo, ph_hi; };
typedef const __attribute__((address_space(4))) Ctx* CP;

DI float bf2f(bf16_t b) { return __uint_as_float(((unsigned)b) << 16); }
DI bf16_t f2bf(float f) { unsigned u = __float_as_uint(f); u += 0x7FFFu + ((u >> 16) & 1u); return (bf16_t)(u >> 16); }
typedef __bf16 hwbf2_t __attribute__((ext_vector_type(2)));
typedef float hwf2_t __attribute__((ext_vector_type(2)));
DI unsigned pk2(float lo, float hi) { const hwf2_t v = {lo, hi}; const hwbf2_t b = __builtin_convertvector(v, hwbf2_t); return __builtin_bit_cast(unsigned, b); }
DI float lo16(unsigned w) { return __uint_as_float(w << 16); }
DI float hi16(unsigned w) { return __uint_as_float(w & 0xffff0000u); }
DI void unpack8(u32x4 w, float* v) { v[0] = lo16(w.x); v[1] = hi16(w.x); v[2] = lo16(w.y); v[3] = hi16(w.y); v[4] = lo16(w.z); v[5] = hi16(w.z); v[6] = lo16(w.w); v[7] = hi16(w.w); }
DI u32x4 pack8(const float* v) { u32x4 w; w.x = pk2(v[0], v[1]); w.y = pk2(v[2], v[3]); w.z = pk2(v[4], v[5]); w.w = pk2(v[6], v[7]); return w; }
DI float wave_sum(float v) { for (int o = 32; o >= 1; o >>= 1) v += __shfl_xor(v, o); return v; }
DI float fexp(float x) { return __builtin_amdgcn_exp2f(x * 1.4426950408889634f); }
DI float sigm(float x) { return __builtin_amdgcn_rcpf(1.f + fexp(-x)); }
DI float silu(float x) { return x * __builtin_amdgcn_rcpf(1.f + fexp(-x)); }
DI int get_tid() { int t = (int)threadIdx.x; asm volatile("" : "+v"(t)); return t; }
DI void lds_barrier() { asm volatile("s_waitcnt lgkmcnt(0)" ::: "memory"); __builtin_amdgcn_s_barrier(); asm volatile("" ::: "memory"); }
DI int modrow_of(int r) { return r < MP ? 0 : 1 + ((r - MP) >> 4); }

namespace pg8 {
constexpr int BM = 256, BK = 64, HALF = 128, HTB = HALF * BK * 2, NXCD = 8, WGM = 8;
__host__ __device__ __forceinline__ int lds_byte(int r, int c) { const int st = (r >> 4) * 2 + (c >> 5), rr = r & 15, cc = c & 31, ob = rr * 64 + cc * 2; return st * 1024 + (ob ^ (((ob >> 9) & 1) << 5)); }
__host__ __device__ __forceinline__ void stage_rc(int b, int& R, int& C) { const int st = b / 1024, sb = b % 1024, swz = sb ^ (((sb >> 9) & 1) << 5); R = (st >> 1) * 16 + swz / 64; C = (st & 1) * 32 + (swz % 64) / 2; }
__host__ __device__ __forceinline__ int perm32(int rho) { const int n = rho >> 4, i = rho & 15; return 8 * (i >> 2) + 4 * n + (i & 3); }
struct Unit { int pm, pn; };
struct StaticOrder {
    int nM, nN, nwg, G, c;
    __device__ void init(int M, int N, int G_, int c_) { nM = M / BM; nN = N / BM; nwg = nM * nN; G = G_; c = c_; }
    __device__ bool next(int i, Unit& u) const {
        const long L = (long)i * G + c; if (L >= nwg) return false;
        int wgid = (int)L; { const int q = nwg / NXCD, r = nwg % NXCD, xcd = wgid % NXCD, off = wgid / NXCD; wgid = (xcd < r ? xcd * (q + 1) : r * (q + 1) + (xcd - r) * q) + off; }
        const int nig = WGM * nN, gid = wgid / nig, fm = gid * WGM, gsz = (nM - fm) < WGM ? (nM - fm) : WGM;
        u.pm = fm + ((wgid % nig) % gsz); u.pn = (wgid % nig) / gsz; return true;
    }
};
}

struct GemmJob { const bf16_t* A; const bf16_t* Bt; int M, N, K, lda, ldb, mode; void* o1; int ld1; void* o2; int ld2; int split; const float* f1; int row0; int flag; int cstart; };

DI void gemm_epilogue(const GemmJob& J, const f32x4 (&acc)[2][2][4][2], const pg8::Unit& u, int wr, int wc, int fr, int fq) {
    const int rloc0 = u.pm * 256 + wr * 64 + fr;
    if (J.mode == 0) {
        float* C = (float*)J.o1; const int col0 = u.pn * 256 + wc * 32 + 4 * fq;
#pragma unroll
        for (int ai = 0; ai < 2; ++ai)
#pragma unroll
            for (int m = 0; m < 4; ++m) { const int row = rloc0 + ai * 128 + m * 16;
                if (row < J.flag) {
#pragma unroll
                    for (int bj = 0; bj < 2; ++bj)
#pragma unroll
                        for (int n = 0; n < 2; ++n) { const int col = col0 + bj * 128 + n * 16; const f32x4 b = *(const f32x4*)(J.f1 + col);
                            *(f32x4*)(C + (size_t)row * J.ld1 + col) = acc[ai][bj][m][n] + b; } }
                asm volatile("" ::: "memory"); }
    } else if (J.mode == 1) {
        int colt = u.pn * 256; bf16_t* base = (bf16_t*)J.o1; int ld = J.ld1;
        if (colt >= J.split) { base = (bf16_t*)J.o2; ld = J.ld2; colt -= J.split; }
        const int col0 = colt + wc * 32 + 8 * fq;
#pragma unroll
        for (int ai = 0; ai < 2; ++ai)
#pragma unroll
            for (int m = 0; m < 4; ++m) { bf16_t* rowp = base + (size_t)(rloc0 + ai * 128 + m * 16) * ld + col0;
#pragma unroll
                for (int bj = 0; bj < 2; ++bj) { const f32x4 v0 = acc[ai][bj][m][0], v1 = acc[ai][bj][m][1];
                    u32x4 w; w.x = pk2(v0[0], v0[1]); w.y = pk2(v0[2], v0[3]); w.z = pk2(v1[0], v1[1]); w.w = pk2(v1[2], v1[3]);
                    *(u32x4*)(rowp + bj * 128) = w; }
                asm volatile("" ::: "memory"); }
    } else if (J.mode == 2) {
        bf16_t* MG = (bf16_t*)J.o1; const bf16_t* Gt = (const bf16_t*)J.o2; const int col0 = u.pn * 256 + wc * 32 + 8 * fq;
        u32x4 gb[2][2], pb[2][2];
#pragma unroll
        for (int bj = 0; bj < 2; ++bj) { gb[0][bj] = *(const u32x4*)(Gt + (size_t)rloc0 * J.ld2 + col0 + bj * 128); pb[0][bj] = (u32x4){0u, 0u, 0u, 0u};
            if (!J.flag) pb[0][bj] = *(const u32x4*)(MG + (size_t)rloc0 * J.ld1 + col0 + bj * 128); }
#pragma unroll
        for (int it = 0; it < 8; ++it) { const int ai = it >> 2, m = it & 3; const int row = rloc0 + ai * 128 + m * 16;
            if (it + 1 < 8) { const int rown = rloc0 + ((it + 1) >> 2) * 128 + ((it + 1) & 3) * 16;
#pragma unroll
                for (int bj = 0; bj < 2; ++bj) { gb[(it + 1) & 1][bj] = *(const u32x4*)(Gt + (size_t)rown * J.ld2 + col0 + bj * 128); pb[(it + 1) & 1][bj] = (u32x4){0u, 0u, 0u, 0u};
                    if (!J.flag) pb[(it + 1) & 1][bj] = *(const u32x4*)(MG + (size_t)rown * J.ld1 + col0 + bj * 128); } }
            __builtin_amdgcn_sched_barrier(0);
#pragma unroll
            for (int bj = 0; bj < 2; ++bj) { float g[8], p[8], a[8]; unpack8(gb[it & 1][bj], g); unpack8(pb[it & 1][bj], p);
                const f32x4 v0 = acc[ai][bj][m][0], v1 = acc[ai][bj][m][1];
                a[0] = v0[0]; a[1] = v0[1]; a[2] = v0[2]; a[3] = v0[3]; a[4] = v1[0]; a[5] = v1[1]; a[6] = v1[2]; a[7] = v1[3];
#pragma unroll
                for (int j = 0; j < 8; ++j) a[j] = a[j] * sigm(g[j]) + p[j];
                *(u32x4*)(MG + (size_t)row * J.ld1 + col0 + bj * 128) = pack8(a); }
            __builtin_amdgcn_sched_barrier(0); }
    } else {
        bf16_t* X = (bf16_t*)J.o1;
        u32x2 xb[2][4]; f32x4 gg[2][4];
        { const float* gp = J.f1 + (size_t)modrow_of(J.row0 + rloc0) * 12288;
#pragma unroll
          for (int q = 0; q < 4; ++q) { const int col = u.pn * 256 + (q >> 1) * 128 + wc * 32 + (q & 1) * 16 + 4 * fq; xb[0][q] = *(const u32x2*)(X + (size_t)rloc0 * J.ld1 + col); gg[0][q] = *(const f32x4*)(gp + col); } }
#pragma unroll
        for (int it = 0; it < 8; ++it) { const int ai = it >> 2, m = it & 3; const int row = rloc0 + ai * 128 + m * 16;
            if (it + 1 < 8) { const int rown = rloc0 + ((it + 1) >> 2) * 128 + ((it + 1) & 3) * 16; const float* gp = J.f1 + (size_t)modrow_of(J.row0 + rown) * 12288;
#pragma unroll
                for (int q = 0; q < 4; ++q) { const int col = u.pn * 256 + (q >> 1) * 128 + wc * 32 + (q & 1) * 16 + 4 * fq; xb[(it + 1) & 1][q] = *(const u32x2*)(X + (size_t)rown * J.ld1 + col); gg[(it + 1) & 1][q] = *(const f32x4*)(gp + col); } }
            __builtin_amdgcn_sched_barrier(0);
#pragma unroll
            for (int q = 0; q < 4; ++q) { const int bj = q >> 1, n = q & 1; const int col = u.pn * 256 + bj * 128 + wc * 32 + n * 16 + 4 * fq;
                const u32x2 xw = xb[it & 1][q]; const f32x4 xv = (f32x4){lo16(xw.x), hi16(xw.x), lo16(xw.y), hi16(xw.y)};
                const f32x4 o = xv * DN_ALPHA + (gg[it & 1][q] + 1.0f) * acc[ai][bj][m][n];
                u32x2 w; w.x = pk2(o[0], o[1]); w.y = pk2(o[2], o[3]); *(u32x2*)(X + (size_t)row * J.ld1 + col) = w; }
            __builtin_amdgcn_sched_barrier(0); }
    }
}

DI void gemm_phase(LAS unsigned char* lds, const GemmJob& g, int G, int cidx) {
    using namespace pg8;
    const int tid = get_tid(), wid = __builtin_amdgcn_readfirstlane(tid >> 6), lane = tid & 63, wr = wid >> 2, wc = wid & 3, fr = lane & 15, fq = lane >> 4;
    const int nt = g.K / BK;
    StaticOrder S; S.init(g.M, g.N, G, cidx);
    const bool perm = (g.mode == 1 || g.mode == 2);
    unsigned voffA[2], voffB[2];
#pragma unroll
    for (int i = 0; i < 2; ++i) { int R, C; stage_rc(tid * 16 + i * 8192, R, C); const int Rb = perm ? ((R & ~31) + perm32(R & 31)) : R;
        voffA[i] = (unsigned)(R * g.lda + C) * 2u; voffB[i] = (unsigned)(Rb * g.ldb + C) * 2u; }
    const size_t kstep = (size_t)(BK * 2);
    const size_t hstepA = (size_t)HALF * g.lda * 2, hstepB = (size_t)HALF * g.ldb * 2;
    const size_t tstepA = 2 * hstepA, tstepB = 2 * hstepB;
    const unsigned ldsw = (unsigned)wid * 1024u;
    const int aoff = lds_byte(wr * 64 + fr, fq * 8), boff = lds_byte(wc * 32 + fr, fq * 8);
#define PG8_SA(b, h) (((b) * 2 + (h)) * HTB)
#define PG8_SB(b, h) ((4 + (b) * 2 + (h)) * HTB)
#define PG8_STAGE(bufoff, gbase, voff) do { _Pragma("unroll") for (int _i = 0; _i < 2; ++_i) \
        __builtin_amdgcn_global_load_lds((const unsigned*)((const char*)(gbase) + (voff)[_i]), (LAS unsigned*)(lds + (bufoff) + ldsw + _i * 8192), 16, 0, 0); } while (0)
#define PG8_LDA(dst, b, h) do { _Pragma("unroll") for (int m = 0; m < 4; ++m) _Pragma("unroll") for (int k = 0; k < 2; ++k) dst[m][k] = *(const LAS bf16x8*)(lds + PG8_SA(b, h) + aoff + m * 2048 + k * 1024); } while (0)
#define PG8_LDB(dst, b, h) do { _Pragma("unroll") for (int n = 0; n < 2; ++n) _Pragma("unroll") for (int k = 0; k < 2; ++k) dst[n][k] = *(const LAS bf16x8*)(lds + PG8_SB(b, h) + boff + n * 2048 + k * 1024); } while (0)
#define PG8_MMA(ai, bj, At, Bt) do { __builtin_amdgcn_s_setprio(1); _Pragma("unroll") for (int m = 0; m < 4; ++m) _Pragma("unroll") for (int n = 0; n < 2; ++n) _Pragma("unroll") for (int k = 0; k < 2; ++k) \
        acc[ai][bj][m][n] = __builtin_amdgcn_mfma_f32_16x16x32_bf16(Bt[n][k], At[m][k], acc[ai][bj][m][n], 0, 0, 0); __builtin_amdgcn_s_setprio(0); } while (0)
#define PG8_WAIT_V(n) asm volatile("s_waitcnt vmcnt(" #n ")" ::: "memory")
#define PG8_WAIT_L(n) asm volatile("s_waitcnt lgkmcnt(" #n ")" ::: "memory")
#define PG8_BAR __builtin_amdgcn_s_barrier()
#define PG8_SCHED __builtin_amdgcn_sched_barrier(0)
    Unit cur, nxt; int ui = 0;
    if (!S.next(0, cur)) return;
    f32x4 acc[2][2][4][2];
#pragma unroll
    for (int a = 0; a < 2; ++a)
#pragma unroll
        for (int b = 0; b < 2; ++b)
#pragma unroll
            for (int m = 0; m < 4; ++m)
#pragma unroll
                for (int n = 0; n < 2; ++n) acc[a][b][m][n] = (f32x4){0.f, 0.f, 0.f, 0.f};
    bf16x8 At[4][2], B0[2][2], B1[2][2];
    const char* cA = (const char*)g.A + (size_t)cur.pm * tstepA; const char* cB = (const char*)g.Bt + (size_t)cur.pn * tstepB;
    PG8_STAGE(PG8_SB(0, 0), cB, voffB); PG8_STAGE(PG8_SA(0, 0), cA, voffA); PG8_STAGE(PG8_SB(0, 1), cB + hstepB, voffB); PG8_STAGE(PG8_SA(0, 1), cA + hstepA, voffA);
    if (wr == 1) PG8_BAR;
    PG8_WAIT_V(4); PG8_BAR;
    PG8_STAGE(PG8_SB(1, 0), cB + kstep, voffB); PG8_STAGE(PG8_SA(1, 0), cA + kstep, voffA); PG8_STAGE(PG8_SB(1, 1), cB + hstepB + kstep, voffB);
    PG8_WAIT_V(6); PG8_BAR;
    for (;;) {
        const bool has_next = S.next(ui + 1, nxt);
        const char* nA = has_next ? (const char*)g.A + (size_t)nxt.pm * tstepA : cA; const char* nB = has_next ? (const char*)g.Bt + (size_t)nxt.pn * tstepB : cB;
        for (int t = 0; t < nt; t += 2) {
            const bool last = (t == nt - 2);
            const char* a1 = cA + (size_t)(t + 1) * kstep;
            const char* a2 = last ? nA : cA + (size_t)(t + 2) * kstep; const char* b2 = last ? nB : cB + (size_t)(t + 2) * kstep;
            const char* a3 = a2 + kstep; const char* b3 = b2 + kstep;
            PG8_LDB(B0, 0, 0); PG8_SCHED; PG8_LDA(At, 0, 0); PG8_STAGE(PG8_SA(1, 1), a1 + hstepA, voffA);
            PG8_WAIT_L(8); PG8_BAR; PG8_WAIT_L(0); PG8_MMA(0, 0, At, B0); PG8_BAR; PG8_SCHED;
            PG8_LDB(B1, 0, 1); PG8_STAGE(PG8_SB(0, 0), b2, voffB);
            PG8_BAR; PG8_WAIT_L(0); PG8_MMA(0, 1, At, B1); PG8_BAR;
            PG8_LDA(At, 0, 1); PG8_STAGE(PG8_SA(0, 0), a2, voffA);
            PG8_BAR; PG8_WAIT_L(0); PG8_MMA(1, 0, At, B0); PG8_BAR; PG8_SCHED;
            PG8_STAGE(PG8_SB(0, 1), b2 + hstepB, voffB);
            PG8_WAIT_V(6); PG8_BAR; PG8_MMA(1, 1, At, B1); PG8_BAR;
            PG8_LDB(B0, 1, 0); PG8_SCHED; PG8_LDA(At, 1, 0); PG8_STAGE(PG8_SA(0, 1), a2 + hstepA, voffA);
            PG8_WAIT_L(8); PG8_BAR; PG8_WAIT_L(0); PG8_MMA(0, 0, At, B0); PG8_BAR; PG8_SCHED;
            PG8_LDB(B1, 1, 1); PG8_STAGE(PG8_SB(1, 0), b3, voffB);
            PG8_BAR; PG8_WAIT_L(0); PG8_MMA(0, 1, At, B1); PG8_BAR;
            PG8_LDA(At, 1, 1); PG8_STAGE(PG8_SA(1, 0), a3, voffA);
            PG8_BAR; PG8_WAIT_L(0); PG8_MMA(1, 0, At, B0); PG8_BAR; PG8_SCHED;
            PG8_STAGE(PG8_SB(1, 1), b3 + hstepB, voffB);
            PG8_WAIT_V(6); PG8_BAR; PG8_MMA(1, 1, At, B1); PG8_BAR;
        }
        gemm_epilogue(g, acc, cur, wr, wc, fr, fq);
        if (!has_next) break;
#pragma unroll
        for (int a = 0; a < 2; ++a)
#pragma unroll
            for (int b = 0; b < 2; ++b)
#pragma unroll
                for (int m = 0; m < 4; ++m)
#pragma unroll
                    for (int n = 0; n < 2; ++n) acc[a][b][m][n] = (f32x4){0.f, 0.f, 0.f, 0.f};
        cur = nxt; cA = nA; cB = nB; ++ui;
    }
    PG8_WAIT_V(0);
    if (wr == 0) PG8_BAR;
    PG8_BAR;
#undef PG8_SA
#undef PG8_SB
#undef PG8_STAGE
#undef PG8_LDA
#undef PG8_LDB
#undef PG8_MMA
#undef PG8_WAIT_V
#undef PG8_WAIT_L
#undef PG8_BAR
#undef PG8_SCHED
}

DI void transpose_cvt(const float* src, int K, int N, int lds_src, bf16_t* dst, int ldd, float* tile, int bid, int nb) {
    const int tid = get_tid(); const int tk = K / 64, tn = (N + 63) / 64, T = tk * tn;
    const int kk0 = tid >> 4, n4 = (tid & 15) * 4;
    f32x4 c0 = (f32x4){0.f, 0.f, 0.f, 0.f}, c1 = c0;
    if (bid < T) { const int k0 = (bid % tk) * 64, n0 = (bid / tk) * 64;
        if (n0 + n4 < N) { c0 = *(const f32x4*)(src + (size_t)(k0 + kk0) * lds_src + n0 + n4); c1 = *(const f32x4*)(src + (size_t)(k0 + kk0 + 32) * lds_src + n0 + n4); } }
    for (int t = bid; t < T; t += nb) {
        const int k0 = (t % tk) * 64, n0 = (t / tk) * 64;
        tile[kk0 * 65 + n4] = c0[0]; tile[kk0 * 65 + n4 + 1] = c0[1]; tile[kk0 * 65 + n4 + 2] = c0[2]; tile[kk0 * 65 + n4 + 3] = c0[3];
        tile[(kk0 + 32) * 65 + n4] = c1[0]; tile[(kk0 + 32) * 65 + n4 + 1] = c1[1]; tile[(kk0 + 32) * 65 + n4 + 2] = c1[2]; tile[(kk0 + 32) * 65 + n4 + 3] = c1[3];
        f32x4 d0 = (f32x4){0.f, 0.f, 0.f, 0.f}, d1 = d0;
        { const int t2 = t + nb;
          if (t2 < T) { const int k2 = (t2 % tk) * 64, n2 = (t2 / tk) * 64;
              if (n2 + n4 < N) { d0 = *(const f32x4*)(src + (size_t)(k2 + kk0) * lds_src + n2 + n4); d1 = *(const f32x4*)(src + (size_t)(k2 + kk0 + 32) * lds_src + n2 + n4); } } }
        lds_barrier();
        { const int nn = tid >> 3, k8 = (tid & 7) * 8; float v[8];
#pragma unroll
            for (int j = 0; j < 8; ++j) v[j] = tile[(k8 + j) * 65 + nn];
            if (n0 + nn < N) *(u32x4*)(dst + (size_t)(n0 + nn) * ldd + k0 + k8) = pack8(v); }
        lds_barrier();
        c0 = d0; c1 = d1;
    }
}

DI void convert_weights(CP c, int l, float* tile, int bid, int nb, int mask) {
    unsigned char* ws = c->ws; const int tid = get_tid();
    const float* wukv = c->in[I_WUKV] + (size_t)l * 256 * 1024;
    if (mask & 1) {
        bf16_t* WinT = (bf16_t*)(ws + WS_WIN);
        const float* w_in = c->in[I_WIN] + (size_t)l * 1024 * 6856;
        transpose_cvt(w_in, 1024, 3784, 6856, WinT, 1024, tile, bid, nb);
        transpose_cvt(w_in + 3784, 1024, 3072, 6856, WinT + (size_t)NZ1 * 1024, 1024, tile, (bid + 64) % nb, nb);
        for (int i = bid * 512 + tid; i < 56 * 1024 / 8; i += nb * 512) *(u32x4*)(WinT + (size_t)3784 * 1024 + (size_t)i * 8) = (u32x4){0u, 0u, 0u, 0u};
        transpose_cvt(c->in[I_WUQ] + (size_t)l * 384 * 768, 384, 768, 768, (bf16_t*)(ws + WS_WUQ), 384, tile, (bid + 160) % nb, nb);
        for (int h = 0; h < 4; ++h) {
            transpose_cvt(wukv + h * 256, 256, 128, 1024, (bf16_t*)(ws + WS_WUK) + (size_t)h * 128 * 256, 256, tile, (bid + 200 + 16 * h) % nb, nb);
            transpose_cvt(wukv + h * 256 + 128, 256, 128, 1024, (bf16_t*)(ws + WS_WUV) + (size_t)h * 128 * 256, 256, tile, (bid + 208 + 16 * h) % nb, nb);
        }
        { const float* wuq = c->in[I_WUQ] + (size_t)l * 384 * 768; bf16_t* dst = (bf16_t*)(ws + WS_WQABS);
          for (int o = bid * 512 + tid; o < 1024 * 384; o += nb * 512) { const int n = o / 384, k = o % 384, h = n >> 8, j = n & 255;
              const f32x4* a = (const f32x4*)(wukv + (size_t)j * 1024 + h * 256); const f32x4* b = (const f32x4*)(wuq + (size_t)k * 768 + h * 192); float s = 0.f;
#pragma unroll 8
              for (int d = 0; d < 32; ++d) { const f32x4 x = a[d], y = b[d]; s += x[0] * y[0] + x[1] * y[1] + x[2] * y[2] + x[3] * y[3]; }
              dst[o] = f2bf(s); } }
    }
    if (mask & 2) {
        transpose_cvt(c->in[I_WUP] + (size_t)l * 1024 * 5632, 1024, 5632, 5632, (bf16_t*)(ws + WS_WUP), 1024, tile, (bid + 128) % nb, nb);
        transpose_cvt(c->in[I_WOUT] + (size_t)l * 1024 * 1024, 1024, 1024, 1024, (bf16_t*)(ws + WS_WOUT), 1024, tile, (bid + 32) % nb, nb);
        for (int i = 0; i < 3; ++i)
            transpose_cvt(c->in[I_WBR] + (size_t)(l * 3 + i) * 512 * 1024, 512, 1024, 1024, (bf16_t*)(ws + WS_WBR) + (size_t)i * 1024 * 512, 512, tile, (bid + 96 + 40 * i) % nb, nb);
        { const float* wb = c->in[I_WBR] + (size_t)(l * 3 + 2) * 512 * 1024; bf16_t* dst = (bf16_t*)(ws + WS_WBRC);
          for (int o = bid * 512 + tid; o < 1024 * 256; o += nb * 512) { const int k = o >> 8, n = (o & 255) * 4, h = k >> 8, j = k & 255;
              const float* a = wukv + (size_t)j * 1024 + h * 256 + 128; const float* b = wb + (size_t)(h * 128) * 1024 + n; f32x4 sacc = (f32x4){0.f, 0.f, 0.f, 0.f};
#pragma unroll 16
              for (int cc = 0; cc < 128; ++cc) sacc += *(const f32x4*)(b + (size_t)cc * 1024) * a[cc];
#pragma unroll
              for (int q = 0; q < 4; ++q) dst[(size_t)(n + q) * 1024 + k] = f2bf(sacc[q]); } }
    }
    if (mask & 4)
        transpose_cvt(c->in[I_WDN] + (size_t)l * 2816 * 1024, 2816, 1024, 1024, (bf16_t*)(ws + WS_WDN), 2816, tile, (bid + 192) % nb, nb);
}

DI void prep_once(CP c, float* tile, int bid, int nb) {
    unsigned char* ws = c->ws; const int tid = get_tid();
    for (int l = 0; l < 2; ++l)
        transpose_cvt(c->in[I_WADA] + (size_t)l * 1024 * 6144, 1024, 6144, 6144, (bf16_t*)(ws + WS_WADA) + (size_t)l * 6144 * 1024, 1024, tile, (bid + 128 * l) % nb, nb);
    bf16_t* SC = (bf16_t*)(ws + WS_SC);
    for (int i = bid * 512 + tid; i < 256 * 1024; i += nb * 512) { const int r = i >> 10, k = i & 1023; float v = 0.f;
        if (r == 0) v = silu(c->in[I_CP][k]); else if (r <= 32) v = silu(c->in[I_CS][(r - 1) * 1024 + k]);
        SC[i] = f2bf(v); }
    float* rope = (float*)(ws + WS_ROPE);
    for (int i = bid * 512 + tid; i < 16384 * 32; i += nb * 512) { const int pos = i >> 5, f = i & 31;
        const float invf = exp2f(-(float)f * 0.41524101186092029f); const float ang = (float)pos * invf;
        const double a = (double)ang; const double kq = rint(a * 0.15915494309189535); const float rr = (float)(a - kq * 6.283185307179586);
        rope[2 * i] = __cosf(rr); rope[2 * i + 1] = __sinf(rr); }
}

DI void ln_pass(CP c, int mode, const float* gam, const float* bet, const float* modsc, const float* modsh, int bid, int nb, bool fin) {
    const int tid = get_tid(), lane = tid & 63, wave = tid >> 6;
    bf16_t* XB = (bf16_t*)(c->ws + WS_XB); bf16_t* H = (bf16_t*)(c->ws + WS_H);
    for (int r = bid * 8 + wave; r < MT; r += nb * 8) {
        f32x4 v[4];
        if (mode == 0) { const float* src = r < MP ? c->in[I_XP] + (size_t)r * DM : c->in[I_XS] + (size_t)(r - MP) * DM;
#pragma unroll
            for (int i = 0; i < 4; ++i) v[i] = *(const f32x4*)(src + lane * 4 + 256 * i); }
        else {
#pragma unroll
            for (int i = 0; i < 4; ++i) { const u32x2 w = *(const u32x2*)(XB + (size_t)r * DM + lane * 4 + 256 * i); v[i] = (f32x4){lo16(w.x), hi16(w.x), lo16(w.y), hi16(w.y)}; } }
        if (mode != 1) {
            float s = 0.f;
#pragma unroll
            for (int i = 0; i < 4; ++i) s += v[i][0] + v[i][1] + v[i][2] + v[i][3];
            const float mean = wave_sum(s) * (1.f / 1024.f); float q = 0.f;
#pragma unroll
            for (int i = 0; i < 4; ++i) { const f32x4 d = v[i] - mean; q += d[0] * d[0] + d[1] * d[1] + d[2] * d[2] + d[3] * d[3]; }
            const float rstd = rsqrtf(wave_sum(q) * (1.f / 1024.f) + 1e-5f);
#pragma unroll
            for (int i = 0; i < 4; ++i) { const int col = lane * 4 + 256 * i; const f32x4 g = *(const f32x4*)(gam + col), b = *(const f32x4*)(bet + col);
                v[i] = (v[i] - mean) * rstd * g + b;
                if (fin) *(f32x4*)(c->out + (size_t)r * DM + col) = v[i];
                else { u32x2 w; w.x = pk2(v[i][0], v[i][1]); w.y = pk2(v[i][2], v[i][3]); *(u32x2*)(XB + (size_t)r * DM + col) = w; } }
        }
        if (modsc) { const int mr = modrow_of(r);
#pragma unroll
            for (int i = 0; i < 4; ++i) { const int col = lane * 4 + 256 * i; const f32x4 sc = *(const f32x4*)(modsc + (size_t)mr * 12288 + col), sh = *(const f32x4*)(modsh + (size_t)mr * 12288 + col);
                const f32x4 h = v[i] * (sc + 1.0f) + sh; u32x2 w; w.x = pk2(h[0], h[1]); w.y = pk2(h[2], h[3]);
                *(u32x2*)(H + (size_t)r * DM + col) = w; } }
    }
}

DI void mla_row(CP c, int l, int r, int lane) {
    unsigned char* ws = c->ws; const bf16_t* z = (const bf16_t*)(ws + WS_Z1) + (size_t)r * NZ1;
    const bool samp = r >= MP; const int b = (r - MP) >> 4, t = (r - MP) & 15;
    {
        float v[8]; float ss = 0.f;
        if (lane < 48) { unpack8(*(const u32x4*)(z + 3080 + lane * 8), v);
#pragma unroll
            for (int j = 0; j < 8; ++j) ss += v[j] * v[j]; }
        const float rs = rsqrtf(wave_sum(ss) * (1.f / 384.f) + 1e-6f);
        if (lane < 48) { const float* g = c->in[I_QNG] + l * 384 + lane * 8;
#pragma unroll
            for (int j = 0; j < 8; ++j) v[j] = v[j] * rs * g[j];
            *(u32x4*)((bf16_t*)(ws + WS_QN) + (size_t)r * 384 + lane * 8) = pack8(v); }
    }
    {
        float v[8]; float ss = 0.f;
        if (lane < 32) { unpack8(*(const u32x4*)(z + 3464 + lane * 8), v);
#pragma unroll
            for (int j = 0; j < 8; ++j) ss += v[j] * v[j]; }
        const float rs = rsqrtf(wave_sum(ss) * (1.f / 256.f) + 1e-6f);
        if (lane < 32) { const float* g = c->in[I_KVNG] + l * 256 + lane * 8;
#pragma unroll
            for (int j = 0; j < 8; ++j) v[j] = v[j] * rs * g[j];
            *(u32x4*)((bf16_t*)(ws + WS_LAT) + (size_t)r * 256 + lane * 8) = pack8(v);
            float* o = samp ? c->out + O_SLAT + ((size_t)(l * 32 + b) * 16 + t) * 256 + lane * 8 : c->out + O_PLAT + ((size_t)l * MP + r) * 256 + lane * 8;
            *(f32x4*)o = (f32x4){v[0], v[1], v[2], v[3]}; *(f32x4*)(o + 4) = (f32x4){v[4], v[5], v[6], v[7]};
            if (samp) { bf16_t* lt = (bf16_t*)(ws + WS_LATT) + ((size_t)b * 256 + lane * 8) * LTS + 2048 + t;
#pragma unroll
                for (int j = 0; j < 8; ++j) lt[(size_t)j * LTS] = f2bf(v[j]); } }
    }
    if (lane < 32) {
        const float x1 = bf2f(z[3720 + lane]), x2 = bf2f(z[3752 + lane]); const int pos = samp ? 2048 + t : r;
        const float* cs = (const float*)(ws + WS_ROPE) + ((size_t)pos * 32 + lane) * 2; const float co = cs[0], si = cs[1];
        const float o1 = x1 * co - x2 * si, o2 = x2 * co + x1 * si;
        bf16_t* kp = (bf16_t*)(ws + WS_KPE) + (size_t)r * 64; kp[lane] = f2bf(o1); kp[32 + lane] = f2bf(o2);
        float* o = samp ? c->out + O_SKPE + ((size_t)(l * 32 + b) * 16 + t) * 64 : c->out + O_PKPE + ((size_t)l * MP + r) * 64;
        o[lane] = o1; o[32 + lane] = o2;
    }
    {
        float v[8]; unpack8(*(const u32x4*)(z + 2560 + lane * 8), v);
#pragma unroll
        for (int j = 0; j < 8; ++j) v[j] = silu(v[j]);
        *(u32x4*)((bf16_t*)(ws + WS_SZ) + (size_t)r * 512 + lane * 8) = pack8(v);
    }
    float* gco = nullptr;
    if (!samp && r >= MP - 3) gco = c->out + O_PGC + ((size_t)l * 3 + (r - (MP - 3))) * 1536;
    if (samp && t >= 13) gco = c->out + O_SGC + ((size_t)(l * 32 + b) * 3 + (t - 13)) * 1536;
    if (gco) for (int i = 0; i < 24; ++i) gco[lane + 64 * i] = bf2f(z[1024 + lane + 64 * i]);
}

DI void conva_tile(CP c, int l, int tile, float* U) {
    unsigned char* ws = c->ws; const int tid = get_tid(), ch = tid, lane = tid & 63, wave = tid >> 6;
    const bool samp = tile >= 512; const int b = tile - 512; const int RT = samp ? 16 : 32; const int t0 = samp ? 0 : tile * 32; const int rbase = samp ? MP + b * 16 : 0;
    const bf16_t* Z1 = (const bf16_t*)(ws + WS_Z1);
#pragma unroll 4
    for (int v = tid; v < (RT + 30) * 64; v += 512) { const int i = v >> 6, c8 = (v & 63) * 8; const int t = t0 - 30 + i; float u[8];
        if (t < 0) {
            if (samp) { const float* hp = c->in[I_SCA] + ((size_t)(l * 32 + b) * 30 + (30 + t)) * 512 + c8; const f32x4 a = *(const f32x4*)hp, bq = *(const f32x4*)(hp + 4);
                u[0] = a[0]; u[1] = a[1]; u[2] = a[2]; u[3] = a[3]; u[4] = bq[0]; u[5] = bq[1]; u[6] = bq[2]; u[7] = bq[3]; }
            else {
#pragma unroll
                for (int j = 0; j < 8; ++j) u[j] = 0.f; }
        } else { const bf16_t* z = Z1 + (size_t)(rbase + t) * NZ1 + c8; float a[8], gt[8]; unpack8(*(const u32x4*)z, a); unpack8(*(const u32x4*)(z + 512), gt);
#pragma unroll
            for (int j = 0; j < 8; ++j) u[j] = a[j] * sigm(gt[j]); }
        *(f32x4*)(U + i * 512 + c8) = (f32x4){u[0], u[1], u[2], u[3]}; *(f32x4*)(U + i * 512 + c8 + 4) = (f32x4){u[4], u[5], u[6], u[7]}; }
    lds_barrier();
    if (samp) { for (int j = 0; j < 30; ++j) c->out[O_SCA + ((size_t)(l * 32 + b) * 30 + j) * 512 + ch] = U[(16 + j) * 512 + ch]; }
    else if (tile == 511) { for (int j = 0; j < 30; ++j) c->out[O_PCA + ((size_t)l * 30 + j) * 512 + ch] = U[(32 + j) * 512 + ch]; }
    float w[31];
#pragma unroll
    for (int i = 0; i < 31; ++i) w[i] = c->in[I_CAW][((size_t)l * 31 + i) * 512 + ch];
    const float bias = c->in[I_CAB][l * 512 + ch];
#pragma unroll 1
    for (int tt = 0; tt < RT; ++tt) { float acc = bias;
#pragma unroll
        for (int i = 0; i < 31; ++i) acc += w[i] * U[(tt + i) * 512 + ch];
        U[tt * 512 + ch] = acc; }
    lds_barrier();
    {
        float v[4][8], sm[4], qv[4];
#pragma unroll
        for (int k = 0; k < 4; ++k) { const int tt = wave + 8 * k; sm[k] = 0.f;
            if (tt < RT) { const f32x4 a = *(const f32x4*)(U + tt * 512 + lane * 8), bq = *(const f32x4*)(U + tt * 512 + lane * 8 + 4);
                v[k][0] = a[0]; v[k][1] = a[1]; v[k][2] = a[2]; v[k][3] = a[3]; v[k][4] = bq[0]; v[k][5] = bq[1]; v[k][6] = bq[2]; v[k][7] = bq[3]; }
            else {
#pragma unroll
                for (int j = 0; j < 8; ++j) v[k][j] = 0.f; }
#pragma unroll
            for (int j = 0; j < 8; ++j) sm[k] += v[k][j]; }
#pragma unroll
        for (int o = 32; o >= 1; o >>= 1)
#pragma unroll
            for (int k = 0; k < 4; ++k) sm[k] += __shfl_xor(sm[k], o);
#pragma unroll
        for (int k = 0; k < 4; ++k) { sm[k] *= (1.f / 512.f); qv[k] = 0.f;
#pragma unroll
            for (int j = 0; j < 8; ++j) { const float d = v[k][j] - sm[k]; qv[k] += d * d; } }
#pragma unroll
        for (int o = 32; o >= 1; o >>= 1)
#pragma unroll
            for (int k = 0; k < 4; ++k) qv[k] += __shfl_xor(qv[k], o);
        const float* g = c->in[I_LNAG] + l * 512 + lane * 8; const float* be = c->in[I_LNAB] + l * 512 + lane * 8;
#pragma unroll
        for (int k = 0; k < 4; ++k) { const int tt = wave + 8 * k;
            if (tt < RT) { const float rstd = rsqrtf(qv[k] * (1.f / 512.f) + 1e-5f); float o8[8];
#pragma unroll
                for (int j = 0; j < 8; ++j) o8[j] = silu((v[k][j] - sm[k]) * rstd * g[j] + be[j]);
                *(u32x4*)((bf16_t*)(ws + WS_YA) + (size_t)(rbase + t0 + tt) * 512 + lane * 8) = pack8(o8); } }
    }
    lds_barrier();
}

DI void gdn_chunk(CP c, int l, int item, float* sm) {
    unsigned char* ws = c->ws; const int tid = get_tid(), lane = tid & 63, wave = tid >> 6;
    float* Qs = sm; float* Ks = Qs + 64 * 132; float* R = Ks + 64 * 132; float* Ls = R + 64 * 260; float* gs = Ls + 64 * 68; float* bs = gs + 64;
    const bool samp = item >= 1024; const int h = item & 3; const int n = item >> 2; const int b = (item - 1024) >> 2;
    const int C = samp ? 16 : 64; const int rbase = samp ? MP + b * 16 : n * 64;
    const bf16_t* Z1 = (const bf16_t*)(ws + WS_Z1);
    if (tid < 384) {
        const int part = tid >> 7, cc = tid & 127, col = part * 512 + h * 128 + cc;
        const float* cw = c->in[I_GCW] + (size_t)l * 4 * 1536 + col; const float w0 = cw[0], w1 = cw[1536], w2 = cw[2 * 1536], w3 = cw[3 * 1536];
        float x0 = 0.f, x1 = 0.f, x2 = 0.f;
        if (samp) { const float* hs = c->in[I_SGC] + (size_t)(l * 32 + b) * 3 * 1536 + col; x0 = hs[0]; x1 = hs[1536]; x2 = hs[2 * 1536]; }
        else if (n > 0) { const bf16_t* zz = Z1 + (size_t)(rbase - 3) * NZ1 + 1024 + col; x0 = bf2f(zz[0]); x1 = bf2f(zz[NZ1]); x2 = bf2f(zz[2 * NZ1]); }
        float* dst = part == 0 ? Qs + cc : (part == 1 ? Ks + cc : R + cc); const int dstride = part == 2 ? 260 : 132;
        const bf16_t* zr = Z1 + (size_t)rbase * NZ1 + 1024 + col;
#pragma unroll 1
        for (int i0 = 0; i0 < 64; i0 += 32) {
            unsigned xr[32];
#pragma unroll
            for (int k = 0; k < 32; ++k) xr[k] = (i0 + k < C) ? (unsigned)zr[(size_t)(i0 + k) * NZ1] : 0u;
#pragma unroll
            for (int k = 0; k < 32; ++k) { float y = 0.f;
                if (i0 + k < C) { const float x3 = lo16(xr[k]); y = silu(w0 * x0 + w1 * x1 + w2 * x2 + w3 * x3); x0 = x1; x1 = x2; x2 = x3; }
                dst[(i0 + k) * dstride] = y; }
        }
    }
    if (wave == 7) {
        float beta = 0.f, g = 0.f;
        if (lane < C) { const bf16_t* z = Z1 + (size_t)(rbase + lane) * NZ1; beta = sigm(bf2f(z[3072 + h]));
            const float x = bf2f(z[3076 + h]) + c->in[I_DTB][l * 4 + h]; const float sp = fmaxf(x, 0.f) + log1pf(expf(-fabsf(x)));
            g = -expf(c->in[I_ALOG][l * 4 + h]) * sp; }
        for (int o = 1; o < 64; o <<= 1) { const float tv = __shfl_up(g, o); if (lane >= o) g += tv; }
        gs[lane] = g; bs[lane] = beta;
    }
    lds_barrier();
    {
        float* rows = (wave < 4) ? Qs + (wave * 16) * 132 : Ks + ((wave - 4) * 16) * 132; const float qsc = (wave < 4) ? 0.08838834764831845f : 1.f;
        float av[16], bv[16], ssv[16];
#pragma unroll
        for (int k = 0; k < 16; ++k) { av[k] = rows[k * 132 + lane]; bv[k] = rows[k * 132 + 64 + lane]; ssv[k] = av[k] * av[k] + bv[k] * bv[k]; }
#pragma unroll
        for (int o = 32; o >= 1; o >>= 1)
#pragma unroll
            for (int k = 0; k < 16; ++k) ssv[k] += __shfl_xor(ssv[k], o);
#pragma unroll
        for (int k = 0; k < 16; ++k) { const float sc = rsqrtf(ssv[k] + 1e-6f) * qsc; rows[k * 132 + lane] = av[k] * sc; rows[k * 132 + 64 + lane] = bv[k] * sc; }
    }
    lds_barrier();
    {
        const int i = tid >> 3, t7 = tid & 7; float kk[8], qk[8];
#pragma unroll
        for (int j = 0; j < 8; ++j) { kk[j] = 0.f; qk[j] = 0.f; }
        const int wv = __builtin_amdgcn_readfirstlane(wave); const int njj = (8 * wv < C) ? wv + 1 : 0;
        if (njj > 0) {
            for (int d4 = 0; d4 < 32; ++d4) { const f32x4 ki = *(const f32x4*)(Ks + i * 132 + d4 * 4), qi = *(const f32x4*)(Qs + i * 132 + d4 * 4);
#pragma unroll
                for (int jj = 0; jj < 8; ++jj) if (jj < njj) { const f32x4 kj = *(const f32x4*)(Ks + (t7 + 8 * jj) * 132 + d4 * 4);
                    kk[jj] += ki[0] * kj[0] + ki[1] * kj[1] + ki[2] * kj[2] + ki[3] * kj[3]; qk[jj] += qi[0] * kj[0] + qi[1] * kj[1] + qi[2] * kj[2] + qi[3] * kj[3]; } }
        }
        const float gi = gs[i], bi = bs[i]; bf16_t* qkrow = (bf16_t*)(ws + WS_QK) + ((size_t)item * 64 + i) * 64;
#pragma unroll
        for (int jj = 0; jj < 8; ++jj) { const int j = t7 + 8 * jj; const float dec = (j <= i) ? __expf(gi - gs[j]) : 0.f;
            Ls[j * 68 + i] = (j < i) ? bi * kk[jj] * dec : 0.f; qkrow[j] = f2bf((j <= i) ? qk[jj] * dec : 0.f); }
    }
    for (int e = tid; e < 64 * 128; e += 512) { const int i = e >> 7, cc = e & 127; const float bi = bs[i];
        R[i * 260 + cc] *= bi; R[i * 260 + 128 + cc] = Ks[i * 132 + cc] * bi * __expf(gs[i]); }
    lds_barrier();
    if (tid < 256) {
        const int col = tid;
#pragma unroll
        for (int i0 = 0; i0 < 64; i0 += 8) {
            if (i0 >= C) break;
            float acc[8];
#pragma unroll
            for (int r = 0; r < 8; ++r) acc[r] = R[(i0 + r) * 260 + col];
#pragma unroll 8
            for (int j = 0; j < i0; ++j) { const float xj = R[j * 260 + col]; const f32x4 la = *(const f32x4*)(Ls + j * 68 + i0), lb = *(const f32x4*)(Ls + j * 68 + i0 + 4);
                acc[0] -= la[0] * xj; acc[1] -= la[1] * xj; acc[2] -= la[2] * xj; acc[3] -= la[3] * xj;
                acc[4] -= lb[0] * xj; acc[5] -= lb[1] * xj; acc[6] -= lb[2] * xj; acc[7] -= lb[3] * xj; }
#pragma unroll
            for (int r = 1; r < 8; ++r)
#pragma unroll
                for (int r2 = 0; r2 < r; ++r2) acc[r] -= Ls[(i0 + r2) * 68 + i0 + r] * acc[r2];
#pragma unroll
            for (int r = 0; r < 8; ++r) R[(i0 + r) * 260 + col] = acc[r];
        }
    } else {
        const int t2 = tid - 256; const float glast = gs[63];
        for (int v = t2; v < 1024; v += 256) { const int i = v >> 4, c8 = (v & 15) * 8; const float e = __expf(gs[i]); float o[8];
#pragma unroll
            for (int j = 0; j < 8; ++j) o[j] = Qs[i * 132 + c8 + j] * e;
            *(u32x4*)((bf16_t*)(ws + WS_QD) + ((size_t)item * 64 + i) * 128 + c8) = pack8(o); }
        for (int v = t2; v < 1024; v += 256) { const int cc = v >> 3, i8 = (v & 7) * 8; float o[8];
#pragma unroll
            for (int j = 0; j < 8; ++j) o[j] = Ks[(i8 + j) * 132 + cc] * __expf(glast - gs[i8 + j]);
            *(u32x4*)((bf16_t*)(ws + WS_KDT) + ((size_t)item * 128 + cc) * 64 + i8) = pack8(o); }
        if (t2 == 0) ((float*)(ws + WS_EGL))[item] = __expf(glast);
    }
    lds_barrier();
    for (int v = tid; v < 2048; v += 512) { const int i = v >> 5, c8 = (v & 31) * 8; float o[8];
#pragma unroll
        for (int j = 0; j < 8; ++j) o[j] = R[i * 260 + c8 + j];
        bf16_t* dst = c8 < 128 ? (bf16_t*)(ws + WS_U) + ((size_t)item * 64 + i) * 128 + c8 : (bf16_t*)(ws + WS_W) + ((size_t)item * 64 + i) * 128 + (c8 - 128);
        *(u32x4*)dst = pack8(o); }
    lds_barrier();
}

DI void gdn_scan(CP c, int l, int seq, int h, int mode, unsigned char* sm) {
    unsigned char* ws = c->ws; const int tid = get_tid(), lane = tid & 63, w = tid >> 6, fr = lane & 15, fq = lane >> 4;
    bf16_t* Wt = (bf16_t*)sm;
    bf16_t* KDt = Wt + 2 * 64 * 136;
    bf16_t* VTs = KDt + 2 * 128 * 72;
    bf16_t* STs = VTs + 128 * 72;
    bf16_t* Ut = STs + 128 * 136;
    const bool samp = seq > 0; const int b = seq - 1; const int nsteps = samp ? 1 : 128; const bool amode = (mode == 3); const float uscale = amode ? 0.f : 1.f;
    const int n0 = (mode >= 2) ? 128 : 0;
    const int item0 = samp ? 1024 + b * 4 + h : h + 4 * n0;
    const bf16_t* Ug = (const bf16_t*)(ws + WS_U); const bf16_t* Wg = (const bf16_t*)(ws + WS_W);
    const bf16_t* KDTg = (const bf16_t*)(ws + WS_KDT); const float* EGL = (const float*)(ws + WS_EGL);
    bf16_t* SNg = samp ? (bf16_t*)(ws + WS_SNS) + (size_t)(b * 4 + h) * 16384 : (amode ? (bf16_t*)(ws + WS_XA) + (size_t)h * 16384 : (bf16_t*)(ws + WS_SNP) + (size_t)(h + 4 * n0) * 16384);
    float* sout = samp ? c->out + O_SGDN + ((size_t)(l * 32 + b) * 4 + h) * 16384 : c->out + O_PGDN + ((size_t)l * 4 + h) * 16384;
    f32x4 Sacc[8];
#pragma unroll
    for (int mt = 0; mt < 8; ++mt) {
        if (samp) { const float* sp = c->in[I_SGDN] + ((size_t)(l * 32 + b) * 4 + h) * 16384;
#pragma unroll
            for (int i = 0; i < 4; ++i) Sacc[mt][i] = sp[(16 * mt + 4 * fq + i) * 128 + 16 * w + fr]; }
        else {
#pragma unroll
            for (int i = 0; i < 4; ++i) Sacc[mt][i] = (amode && (16 * mt + 4 * fq + i == 16 * w + fr)) ? 1.f : 0.f; }
    }
    const u32x4 z4 = (u32x4){0u, 0u, 0u, 0u};
    u32x4 Pw0 = z4, Pw1 = z4, Pk0 = z4, Pk1 = z4, Qw0 = z4, Qw1 = z4, Qk0 = z4, Qk1 = z4, Pu0 = z4, Pu1 = z4, Qu0 = z4, Qu1 = z4; float Pe = 1.f, Qe = 1.f, egl = 1.f;
#define SC_ISSUE(X, it) do { const size_t _i = (size_t)(it); \
        X##w0 = *(const u32x4*)(Wg + _i * 8192 + (size_t)tid * 8); X##w1 = *(const u32x4*)(Wg + _i * 8192 + (size_t)(tid + 512) * 8); \
        X##k0 = *(const u32x4*)(KDTg + _i * 8192 + (size_t)tid * 8); X##k1 = *(const u32x4*)(KDTg + _i * 8192 + (size_t)(tid + 512) * 8); \
        X##u0 = *(const u32x4*)(Ug + _i * 8192 + (size_t)tid * 8); X##u1 = *(const u32x4*)(Ug + _i * 8192 + (size_t)(tid + 512) * 8); \
        X##e = EGL[_i]; } while (0)
#define SC_COMMIT(X, buf) do { bf16_t* _W = Wt + (buf) * 64 * 136; bf16_t* _K = KDt + (buf) * 128 * 72; bf16_t* _U = Ut + (buf) * 64 * 136; \
        { const int v = tid, r = v >> 4, sg = (v & 15) * 8; *(u32x4*)(_W + r * 136 + sg) = X##w0; *(u32x4*)(_U + r * 136 + sg) = X##u0; } \
        { const int v = tid + 512, r = v >> 4, sg = (v & 15) * 8; *(u32x4*)(_W + r * 136 + sg) = X##w1; *(u32x4*)(_U + r * 136 + sg) = X##u1; } \
        { const int v = tid, r = v >> 3, sg = (v & 7) * 8; *(u32x4*)(_K + r * 72 + sg) = X##k0; } \
        { const int v = tid + 512, r = v >> 3, sg = (v & 7) * 8; *(u32x4*)(_K + r * 72 + sg) = X##k1; } \
        egl = X##e; } while (0)
#define SC_STEP(X, n) do { const int _n = (n); const int _buf = _n & 1; const bf16_t* _W = Wt + _buf * 64 * 136; const bf16_t* _K = KDt + _buf * 128 * 72; const bf16_t* _U = Ut + _buf * 64 * 136; \
        bf16_t* _sn = SNg + (size_t)_n * 4 * 16384; \
        _Pragma("unroll") for (int mt = 0; mt < 8; ++mt) { u32x2 p; p.x = pk2(Sacc[mt][0], Sacc[mt][1]); p.y = pk2(Sacc[mt][2], Sacc[mt][3]); \
            *(u32x2*)(STs + (16 * w + fr) * 136 + 16 * mt + 4 * fq) = p; \
            if (!amode) *(u32x2*)(_sn + (size_t)(16 * w + fr) * 128 + 16 * mt + 4 * fq) = p; \
            else { bf16_t* _q = _sn + (size_t)(16 * mt + 4 * fq) * 128 + 16 * w + fr; _q[0] = (bf16_t)(p.x & 0xffffu); _q[128] = (bf16_t)(p.x >> 16); _q[256] = (bf16_t)(p.y & 0xffffu); _q[384] = (bf16_t)(p.y >> 16); } } \
        asm volatile("s_waitcnt lgkmcnt(0)" ::: "memory"); __builtin_amdgcn_wave_barrier(); \
        bf16x8 Sb[4]; bf16x8 Af[8]; bf16_t ucur[16]; \
        _Pragma("unroll") for (int mt = 0; mt < 4; ++mt) _Pragma("unroll") for (int i = 0; i < 4; ++i) ucur[mt * 4 + i] = _U[(16 * mt + 4 * fq + i) * 136 + 16 * w + fr]; \
        _Pragma("unroll") for (int s_ = 0; s_ < 4; ++s_) Sb[s_] = *(const bf16x8*)(STs + (16 * w + fr) * 136 + 32 * s_ + 8 * fq); \
        _Pragma("unroll") for (int hb = 0; hb < 2; ++hb) { \
            _Pragma("unroll") for (int m2 = 0; m2 < 2; ++m2) _Pragma("unroll") for (int s_ = 0; s_ < 4; ++s_) Af[m2 * 4 + s_] = *(const bf16x8*)(_W + (16 * (2 * hb + m2) + fr) * 136 + 32 * s_ + 8 * fq); \
            __builtin_amdgcn_sched_barrier(0); \
            _Pragma("unroll") for (int m2 = 0; m2 < 2; ++m2) { const int mt = 2 * hb + m2; f32x4 a = (f32x4){0.f, 0.f, 0.f, 0.f}; \
                _Pragma("unroll") for (int s_ = 0; s_ < 4; ++s_) a = __builtin_amdgcn_mfma_f32_16x16x32_bf16(Af[m2 * 4 + s_], Sb[s_], a, 0, 0, 0); \
                u32x2 p; p.x = pk2(uscale * bf2f(ucur[mt * 4 + 0]) - a[0], uscale * bf2f(ucur[mt * 4 + 1]) - a[1]); p.y = pk2(uscale * bf2f(ucur[mt * 4 + 2]) - a[2], uscale * bf2f(ucur[mt * 4 + 3]) - a[3]); \
                *(u32x2*)(VTs + (16 * w + fr) * 72 + 16 * mt + 4 * fq) = p; } \
            __builtin_amdgcn_sched_barrier(0); } \
        _Pragma("unroll") for (int m2 = 0; m2 < 4; ++m2) _Pragma("unroll") for (int s_ = 0; s_ < 2; ++s_) Af[m2 * 2 + s_] = *(const bf16x8*)(_K + (16 * m2 + fr) * 72 + 32 * s_ + 8 * fq); \
        asm volatile("s_waitcnt lgkmcnt(0)" ::: "memory"); __builtin_amdgcn_wave_barrier(); \
        bf16x8 Vb[2]; \
        _Pragma("unroll") for (int s_ = 0; s_ < 2; ++s_) Vb[s_] = *(const bf16x8*)(VTs + (16 * w + fr) * 72 + 32 * s_ + 8 * fq); \
        _Pragma("unroll") for (int hb = 0; hb < 2; ++hb) { \
            if (hb == 1) { _Pragma("unroll") for (int m2 = 0; m2 < 4; ++m2) _Pragma("unroll") for (int s_ = 0; s_ < 2; ++s_) Af[m2 * 2 + s_] = *(const bf16x8*)(_K + (16 * (4 + m2) + fr) * 72 + 32 * s_ + 8 * fq); } \
            __builtin_amdgcn_sched_barrier(0); \
            _Pragma("unroll") for (int m2 = 0; m2 < 4; ++m2) { const int mt = 4 * hb + m2; f32x4 a = Sacc[mt] * egl; \
                _Pragma("unroll") for (int s_ = 0; s_ < 2; ++s_) a = __builtin_amdgcn_mfma_f32_16x16x32_bf16(Af[m2 * 2 + s_], Vb[s_], a, 0, 0, 0); \
                Sacc[mt] = a; } \
            __builtin_amdgcn_sched_barrier(0); } \
        SC_COMMIT(X, _buf ^ 1); \
        if (_n + 3 < nsteps) SC_ISSUE(X, item0 + 4 * (_n + 3)); \
        lds_barrier(); } while (0)
    lds_barrier();
    SC_ISSUE(Q, item0); SC_COMMIT(Q, 0);
    if (nsteps > 1) { SC_ISSUE(P, item0 + 4); SC_ISSUE(Q, item0 + 8); }
    lds_barrier();
    for (int n = 0; n < nsteps; n += 2) {
        SC_STEP(P, n);
        if (n + 1 < nsteps) SC_STEP(Q, n + 1);
    }
#undef SC_ISSUE
#undef SC_COMMIT
#undef SC_STEP
    if (mode == 0 || mode == 2) {
#pragma unroll
        for (int mt = 0; mt < 8; ++mt)
#pragma unroll
            for (int i = 0; i < 4; ++i) sout[(16 * mt + 4 * fq + i) * 128 + 16 * w + fr] = Sacc[mt][i];
    } else if (mode == 1) {
        bf16_t* x = (bf16_t*)(ws + WS_XS128) + (size_t)h * 16384;
#pragma unroll
        for (int mt = 0; mt < 8; ++mt) { u32x2 p; p.x = pk2(Sacc[mt][0], Sacc[mt][1]); p.y = pk2(Sacc[mt][2], Sacc[mt][3]); *(u32x2*)(x + (size_t)(16 * w + fr) * 128 + 16 * mt + 4 * fq) = p; }
    } else {
        bf16_t* x = (bf16_t*)(ws + WS_XA256) + (size_t)h * 16384;
#pragma unroll
        for (int mt = 0; mt < 8; ++mt)
#pragma unroll
            for (int i = 0; i < 4; ++i) x[(size_t)(16 * mt + 4 * fq + i) * 128 + 16 * w + fr] = f2bf(Sacc[mt][i]);
    }
    lds_barrier();
}

DI void gdn_out(CP c, int l, int item, unsigned char* sm) {
    unsigned char* ws = c->ws; const int tid = get_tid(), lane = tid & 63, w = tid >> 6, fr = lane & 15, fq = lane >> 4;
    bf16_t* Ws = (bf16_t*)sm; bf16_t* QDs = Ws + 64 * 136; bf16_t* QKs = QDs + 64 * 136; bf16_t* VTs = QKs + 64 * 72; bf16_t* STs = VTs + 128 * 72;
    float* OS = (float*)(STs + 128 * 136);
    const bool samp = item >= 1024; const int h = item & 3, n = item >> 2, b = (item - 1024) >> 2; const int C = samp ? 16 : 64;
    const bf16_t* Ug = (const bf16_t*)(ws + WS_U) + (size_t)item * 8192; const bf16_t* Wg = (const bf16_t*)(ws + WS_W) + (size_t)item * 8192;
    const bf16_t* QDg = (const bf16_t*)(ws + WS_QD) + (size_t)item * 8192; const bf16_t* QKg = (const bf16_t*)(ws + WS_QK) + (size_t)item * 4096;
    const bf16_t* SNg = samp ? (const bf16_t*)(ws + WS_SNS) + (size_t)(item - 1024) * 16384 : (const bf16_t*)(ws + WS_SNP) + (size_t)item * 16384;
    const bool fin = item >= NITEM_GDN;
    const bool comb = fin || (!samp && n >= 128);
    if (comb) {
        const int hh = fin ? item - NITEM_GDN : h;
        const bf16_t* XAg = fin ? (const bf16_t*)(ws + WS_XA256) + (size_t)hh * 16384 : (const bf16_t*)(ws + WS_XA) + (size_t)((n - 128) * 4 + h) * 16384;
        const bf16_t* XSg = (const bf16_t*)(ws + WS_XS128) + (size_t)hh * 16384;
        bf16_t* As = Ws; bf16_t* S8s = (bf16_t*)OS;
#pragma unroll
        for (int k = 0; k < 4; ++k) { const int v = tid + 512 * k, r = v >> 4, sg = (v & 15) * 8;
            *(u32x4*)(As + r * 136 + sg) = *(const u32x4*)(XAg + (size_t)v * 8); *(u32x4*)(S8s + r * 136 + sg) = *(const u32x4*)(XSg + (size_t)v * 8); }
        lds_barrier();
        bf16x8 Bf[4];
#pragma unroll
        for (int s2 = 0; s2 < 4; ++s2) Bf[s2] = *(const bf16x8*)(S8s + (16 * w + fr) * 136 + 32 * s2 + 8 * fq);
#pragma unroll
        for (int mt = 0; mt < 8; ++mt) { f32x4 a = (f32x4){0.f, 0.f, 0.f, 0.f};
#pragma unroll
            for (int s2 = 0; s2 < 4; ++s2) a = __builtin_amdgcn_mfma_f32_16x16x32_bf16(*(const bf16x8*)(As + (16 * mt + fr) * 136 + 32 * s2 + 8 * fq), Bf[s2], a, 0, 0, 0);
            if (fin) { float* o = c->out + O_PGDN + ((size_t)l * 4 + hh) * 16384;
#pragma unroll
                for (int i = 0; i < 4; ++i) o[(16 * mt + 4 * fq + i) * 128 + 16 * w + fr] += a[i]; }
            else { const u32x2 bb = *(const u32x2*)(SNg + (size_t)(16 * w + fr) * 128 + 16 * mt + 4 * fq);
                u32x2 p; p.x = pk2(a[0] + lo16(bb.x), a[1] + hi16(bb.x)); p.y = pk2(a[2] + lo16(bb.y), a[3] + hi16(bb.y));
                *(u32x2*)(STs + (16 * w + fr) * 136 + 16 * mt + 4 * fq) = p; }
            asm volatile("" ::: "memory"); }
        lds_barrier();
        if (fin) return;
    }
#pragma unroll
    for (int k = 0; k < 2; ++k) { const int v = tid + 512 * k, r = v >> 4, sg = (v & 15) * 8;
        *(u32x4*)(Ws + r * 136 + sg) = *(const u32x4*)(Wg + (size_t)v * 8); *(u32x4*)(QDs + r * 136 + sg) = *(const u32x4*)(QDg + (size_t)v * 8); }
    { const int v = tid, r = v >> 3, sg = (v & 7) * 8; *(u32x4*)(QKs + r * 72 + sg) = *(const u32x4*)(QKg + (size_t)v * 8); }
    if (!comb) {
#pragma unroll
        for (int k = 0; k < 4; ++k) { const int v = tid + 512 * k, r = v >> 4, sg = (v & 15) * 8; *(u32x4*)(STs + r * 136 + sg) = *(const u32x4*)(SNg + (size_t)v * 8); }
    }
    float uu[16];
#pragma unroll
    for (int mt = 0; mt < 4; ++mt)
#pragma unroll
        for (int i = 0; i < 4; ++i) uu[mt * 4 + i] = bf2f(Ug[(size_t)(16 * mt + 4 * fq + i) * 128 + 16 * w + fr]);
    unsigned zg[16];
#pragma unroll
    for (int k = 0; k < 8; ++k) { const int i = w * 8 + k; const int r = samp ? MP + b * 16 + (i < C ? i : 0) : n * 64 + i;
        const bf16_t* sz = (const bf16_t*)(ws + WS_SZ) + (size_t)r * 512 + h * 128; zg[2 * k] = (unsigned)sz[lane]; zg[2 * k + 1] = (unsigned)sz[64 + lane]; }
    lds_barrier();
    bf16x8 Sb[4];
#pragma unroll
    for (int s = 0; s < 4; ++s) Sb[s] = *(const bf16x8*)(STs + (16 * w + fr) * 136 + 32 * s + 8 * fq);
#pragma unroll
    for (int mt = 0; mt < 4; ++mt) { f32x4 a = (f32x4){0.f, 0.f, 0.f, 0.f};
#pragma unroll
        for (int s = 0; s < 4; ++s) a = __builtin_amdgcn_mfma_f32_16x16x32_bf16(*(const bf16x8*)(Ws + (16 * mt + fr) * 136 + 32 * s + 8 * fq), Sb[s], a, 0, 0, 0);
        u32x2 p; p.x = pk2(uu[mt * 4 + 0] - a[0], uu[mt * 4 + 1] - a[1]); p.y = pk2(uu[mt * 4 + 2] - a[2], uu[mt * 4 + 3] - a[3]);
        *(u32x2*)(VTs + (16 * w + fr) * 72 + 16 * mt + 4 * fq) = p; asm volatile("" ::: "memory"); }
    asm volatile("s_waitcnt lgkmcnt(0)" ::: "memory"); __builtin_amdgcn_wave_barrier();
    bf16x8 Vb[2];
#pragma unroll
    for (int s = 0; s < 2; ++s) Vb[s] = *(const bf16x8*)(VTs + (16 * w + fr) * 72 + 32 * s + 8 * fq);
#pragma unroll
    for (int mt = 0; mt < 4; ++mt) { f32x4 o = (f32x4){0.f, 0.f, 0.f, 0.f};
#pragma unroll
        for (int s = 0; s < 4; ++s) o = __builtin_amdgcn_mfma_f32_16x16x32_bf16(*(const bf16x8*)(QDs + (16 * mt + fr) * 136 + 32 * s + 8 * fq), Sb[s], o, 0, 0, 0);
#pragma unroll
        for (int s = 0; s < 2; ++s) o = __builtin_amdgcn_mfma_f32_16x16x32_bf16(*(const bf16x8*)(QKs + (16 * mt + fr) * 72 + 32 * s + 8 * fq), Vb[s], o, 0, 0, 0);
#pragma unroll
        for (int i = 0; i < 4; ++i) OS[(16 * mt + 4 * fq + i) * 132 + 16 * w + fr] = o[i];
        asm volatile("" ::: "memory"); }
    lds_barrier();
    const float gn0 = c->in[I_GNG][l * 128 + lane], gn1 = c->in[I_GNG][l * 128 + 64 + lane];
    if (w * 8 < C) {
        float av[8], bv[8], ssv[8];
#pragma unroll
        for (int k = 0; k < 8; ++k) { const int i = w * 8 + k; av[k] = OS[i * 132 + lane]; bv[k] = OS[i * 132 + 64 + lane]; ssv[k] = av[k] * av[k] + bv[k] * bv[k]; }
#pragma unroll
        for (int o = 32; o >= 1; o >>= 1)
#pragma unroll
            for (int k = 0; k < 8; ++k) ssv[k] += __shfl_xor(ssv[k], o);
#pragma unroll
        for (int k = 0; k < 8; ++k) { const int i = w * 8 + k; const int r = samp ? MP + b * 16 + i : n * 64 + i;
            const float rs = rsqrtf(ssv[k] * (1.f / 128.f) + 1e-6f);
            bf16_t* yb = (bf16_t*)(ws + WS_YB) + (size_t)r * 512 + h * 128;
            yb[lane] = f2bf(av[k] * rs * gn0 * lo16(zg[2 * k])); yb[64 + lane] = f2bf(bv[k] * rs * gn1 * lo16(zg[2 * k + 1])); }
    }
    lds_barrier();
}

template <int DK, int DV, int KT, bool SAMPLE>
DI void attn_item(CP c, int l, int qb, int h, unsigned char* sm) {
    constexpr int NQ = SAMPLE ? 64 : 128, QS = DK + 8, VS = KT + 8, NMT = KT / 32, NDT = DV / 32;
    unsigned char* ws = c->ws; const int tid = get_tid(), lane = tid & 63, w = tid >> 6, g = w >> 2, wq = w & 3, l31 = lane & 31, hh = lane >> 5, gt = tid & 255;
    bf16_t* Qs = (bf16_t*)sm; bf16_t* Ks = Qs + NQ * QS + g * (KT * QS + DV * VS); bf16_t* Vs = Ks + KT * QS;
    float* Ex = (float*)(Qs + NQ * QS);
    const bf16_t* Qg = (const bf16_t*)(ws + WS_Q); const bf16_t* KNg = (const bf16_t*)(ws + WS_KN); const bf16_t* KPEg = (const bf16_t*)(ws + WS_KPE);
    const bf16_t* VTg = (const bf16_t*)(ws + WS_VT); const bf16_t* LATg = (const bf16_t*)(ws + WS_LAT); const bf16_t* LTg = (const bf16_t*)(ws + WS_LATT);
    const float* rope = (const float*)(ws + WS_ROPE);
    const int b = qb;
    lds_barrier();
    if (!SAMPLE) {
        for (int v = tid; v < 128 * 24; v += 512) { const int r = v / 24, s = v % 24; *(u32x4*)(Qs + r * QS + s * 8) = *(const u32x4*)(Qg + (size_t)(qb * 128 + r) * 768 + h * 192 + s * 8); }
    } else {
        const bf16_t* QAg = (const bf16_t*)(ws + WS_QABS);
        for (int v = tid; v < 64 * 40; v += 512) { const int r = v / 40, s = v % 40, hq = r >> 4, t = r & 15;
            const bf16_t* src = s < 32 ? QAg + (size_t)(b * 16 + t) * 1024 + hq * 256 + s * 8 : Qg + (size_t)(MP + b * 16 + t) * 768 + hq * 192 + 128 + (s - 32) * 8;
            *(u32x4*)(Qs + r * QS + s * 8) = *(const u32x4*)src; }
    }
    lds_barrier();
    for (int v = tid; v < NQ * 32; v += 512) { const int r = v >> 5, f = v & 31; const int pos = SAMPLE ? 2048 + (r & 15) : qb * 128 + r;
        const float co = rope[((size_t)pos * 32 + f) * 2], si = rope[((size_t)pos * 32 + f) * 2 + 1];
        bf16_t* q = Qs + r * QS + (DK - 64); const float x1 = bf2f(q[f]), x2 = bf2f(q[32 + f]);
        q[f] = f2bf(x1 * co - x2 * si); q[32 + f] = f2bf(x2 * co + x1 * si); }
    constexpr bool QREG = false;
    bf16x8 Qf[QREG ? DK / 16 : 1];
    if (QREG) { lds_barrier();
#pragma unroll
        for (int ks = 0; ks < (QREG ? DK / 16 : 1); ++ks) Qf[ks] = *(const bf16x8*)(Qs + (32 * wq + l31) * QS + 16 * ks + 8 * hh); }
    const int ntiles = SAMPLE ? 66 : 2 * qb + 2; const int nj = ntiles / 2;
    const bool wave_on = SAMPLE ? (wq < 2) : true;
    const int qc = 2 * qb + (wq >> 1);
    f32x16 Oacc[NDT];
#pragma unroll
    for (int d = 0; d < NDT; ++d)
#pragma unroll
        for (int i = 0; i < 16; ++i) Oacc[d][i] = 0.f;
    float m_run = -INFINITY, l_run = 0.f;
    const float scale = 0.07216878364870322f * 1.4426950408889634f;
    u32x4 kreg[6], vreg[4];
    const int lkey = gt >> 2, ls0 = gt & 3, ldv = gt >> 1, lv0 = gt & 1;
    const bf16_t* kn_base = KNg + (size_t)lkey * 512 + h * 128 + ls0 * 8; const bf16_t* kp_base = KPEg + (size_t)lkey * 64 + ls0 * 8;
    const bf16_t* vt_base = VTg + (size_t)(h * 128 + ldv) * MP + lv0 * 8;
#define ATT_ISSUE(kt) do { const size_t _k0 = (size_t)(kt) * 64; \
        _Pragma("unroll") for (int i = 0; i < 4; ++i) kreg[i] = *(const u32x4*)(kn_base + _k0 * 512 + i * 32); \
        _Pragma("unroll") for (int i = 0; i < 2; ++i) kreg[4 + i] = *(const u32x4*)(kp_base + _k0 * 64 + i * 32); \
        _Pragma("unroll") for (int i = 0; i < 4; ++i) vreg[i] = *(const u32x4*)(vt_base + _k0 + i * 16); } while (0)
    if (!SAMPLE) ATT_ISSUE(g);
    for (int j = 0; j < nj; ++j) {
        const int kt = 2 * j + g;
        lds_barrier();
        if (!SAMPLE) {
#pragma unroll
            for (int i = 0; i < 6; ++i) *(u32x4*)(Ks + lkey * QS + ls0 * 8 + i * 32) = kreg[i];
#pragma unroll
            for (int i = 0; i < 4; ++i) *(u32x4*)(Vs + ldv * VS + lv0 * 8 + i * 16) = vreg[i];
        } else {
            const int k0 = kt * 32;
            for (int v = gt; v < 32 * 40; v += 256) { const int key = v / 40, s = v % 40, kk = k0 + key; u32x4 o = (u32x4){0u, 0u, 0u, 0u};
                if (kk < 2048) { const float* src = s < 32 ? c->in[I_CLAT] + ((size_t)(l * 32 + b) * 2048 + kk) * 256 + s * 8 : c->in[I_CKPE] + ((size_t)(l * 32 + b) * 2048 + kk) * 64 + (s - 32) * 8;
                    const f32x4 a = *(const f32x4*)src, bq = *(const f32x4*)(src + 4); o.x = pk2(a[0], a[1]); o.y = pk2(a[2], a[3]); o.z = pk2(bq[0], bq[1]); o.w = pk2(bq[2], bq[3]); }
                else if (kk < 2064) { const int rr = MP + b * 16 + (kk - 2048); o = *(const u32x4*)(s < 32 ? LATg + (size_t)rr * 256 + s * 8 : KPEg + (size_t)rr * 64 + (s - 32) * 8); }
                *(u32x4*)(Ks + key * QS + s * 8) = o; }
            for (int v = gt; v < 256 * 4; v += 256) { const int dv = v >> 2, s = v & 3; u32x4 o = (u32x4){0u, 0u, 0u, 0u};
                if (k0 < LTS) o = *(const u32x4*)(LTg + ((size_t)b * 256 + dv) * LTS + k0 + s * 8);
                *(u32x4*)(Vs + dv * VS + s * 8) = o; }
        }
        lds_barrier();
        if (!SAMPLE) { if (j + 1 < nj) ATT_ISSUE(kt + 2); }
        const bool active = SAMPLE ? (wave_on && kt * 32 < 2064) : (kt <= qc);
        if (active) {
            f32x16 S[NMT];
#pragma unroll
            for (int mt = 0; mt < NMT; ++mt)
#pragma unroll
                for (int i = 0; i < 16; ++i) S[mt][i] = 0.f;
            {
                constexpr int NKP = DK / 32;
                bf16x8 Kf[2][2 * NMT]; bf16x8 Ql[2][2];
#pragma unroll
                for (int e = 0; e < 2; ++e) {
#pragma unroll
                    for (int mt = 0; mt < NMT; ++mt) Kf[0][e * NMT + mt] = *(const bf16x8*)(Ks + (32 * mt + l31) * QS + 16 * e + 8 * hh);
                    if (!QREG) Ql[0][e] = *(const bf16x8*)(Qs + (32 * wq + l31) * QS + 16 * e + 8 * hh); }
#pragma unroll
                for (int kp = 0; kp < NKP; ++kp) {
                    if (kp + 1 < NKP) {
#pragma unroll
                        for (int e = 0; e < 2; ++e) {
#pragma unroll
                            for (int mt = 0; mt < NMT; ++mt) Kf[(kp + 1) & 1][e * NMT + mt] = *(const bf16x8*)(Ks + (32 * mt + l31) * QS + 16 * (2 * kp + 2 + e) + 8 * hh);
                            if (!QREG) Ql[(kp + 1) & 1][e] = *(const bf16x8*)(Qs + (32 * wq + l31) * QS + 16 * (2 * kp + 2 + e) + 8 * hh); } }
                    __builtin_amdgcn_sched_barrier(0);
#pragma unroll
                    for (int e = 0; e < 2; ++e)
#pragma unroll
                        for (int mt = 0; mt < NMT; ++mt) S[mt] = __builtin_amdgcn_mfma_f32_32x32x16_bf16(Kf[kp & 1][e * NMT + mt], !QREG ? Ql[kp & 1][e] : Qf[QREG ? 2 * kp + e : 0], S[mt], 0, 0, 0);
                    __builtin_amdgcn_sched_barrier(0);
                }
            }
            float mloc = -INFINITY;
#pragma unroll
            for (int mt = 0; mt < NMT; ++mt)
#pragma unroll
                for (int i = 0; i < 16; ++i) { float s = S[mt][i] * scale;
                    if (SAMPLE) { const int key = kt * KT + 32 * mt + (i & 3) + 8 * (i >> 2) + 4 * hh; if (key >= 2064) s = -INFINITY; }
                    S[mt][i] = s; mloc = fmaxf(mloc, s); }
            mloc = fmaxf(mloc, __shfl_xor(mloc, 32));
            const float mnew = fmaxf(m_run, mloc); const float alpha = __builtin_amdgcn_exp2f(m_run - mnew); float psum = 0.f;
#pragma unroll
            for (int mt = 0; mt < NMT; ++mt)
#pragma unroll
                for (int i = 0; i < 16; ++i) { const float p = __builtin_amdgcn_exp2f(S[mt][i] - mnew); S[mt][i] = p; psum += p; }
            l_run = l_run * alpha + psum; m_run = mnew;
#pragma unroll
            for (int d = 0; d < NDT; ++d) Oacc[d] = Oacc[d] * alpha;
            {
                constexpr int NDB = NDT / 4;
                constexpr int NG = 2 * NMT * NDB;
                u32x4 Vf[2][4];
#define ATT_LDV(buf, gi) do { const int _kg = (gi) / NDB, _db = (gi) % NDB; _Pragma("unroll") for (int d = 0; d < 4; ++d) { const bf16_t* vp = Vs + (32 * (4 * _db + d) + l31) * VS + 16 * _kg + 4 * hh; \
                        const u32x2 lo = *(const u32x2*)vp, hi = *(const u32x2*)(vp + 8); Vf[buf][d].x = lo.x; Vf[buf][d].y = lo.y; Vf[buf][d].z = hi.x; Vf[buf][d].w = hi.y; } } while (0)
                ATT_LDV(0, 0);
#pragma unroll
                for (int gi = 0; gi < NG; ++gi) { const int kg = gi / NDB, db = gi % NDB, mt = kg >> 1, s2 = kg & 1;
                    if (gi + 1 < NG) ATT_LDV((gi + 1) & 1, gi + 1);
                    u32x4 pw; pw.x = pk2(S[mt][8 * s2 + 0], S[mt][8 * s2 + 1]); pw.y = pk2(S[mt][8 * s2 + 2], S[mt][8 * s2 + 3]);
                    pw.z = pk2(S[mt][8 * s2 + 4], S[mt][8 * s2 + 5]); pw.w = pk2(S[mt][8 * s2 + 6], S[mt][8 * s2 + 7]);
                    const bf16x8 pf = __builtin_bit_cast(bf16x8, pw);
                    __builtin_amdgcn_sched_barrier(0);
#pragma unroll
                    for (int d = 0; d < 4; ++d) Oacc[4 * db + d] = __builtin_amdgcn_mfma_f32_32x32x16_bf16(__builtin_bit_cast(bf16x8, Vf[gi & 1][d]), pf, Oacc[4 * db + d], 0, 0, 0);
                    __builtin_amdgcn_sched_barrier(0);
                }
#undef ATT_LDV
            }
        }
    }
#undef ATT_ISSUE
    const float l_tot = l_run + __shfl_xor(l_run, 32);
    lds_barrier();
    if (g == 1 && wave_on) { float* e = Ex + (size_t)wq * (NDT * 16 + 2) * 64;
#pragma unroll
        for (int d = 0; d < NDT; ++d)
#pragma unroll
            for (int i = 0; i < 16; ++i) e[(d * 16 + i) * 64 + lane] = Oacc[d][i];
        e[(NDT * 16) * 64 + lane] = m_run; e[(NDT * 16 + 1) * 64 + lane] = l_tot; }
    lds_barrier();
    if (g == 0 && wave_on) { const float* e = Ex + (size_t)wq * (NDT * 16 + 2) * 64;
        const float m1 = e[(NDT * 16) * 64 + lane], l1 = e[(NDT * 16 + 1) * 64 + lane];
        const float m = fmaxf(m_run, m1); const float a0 = exp2f(m_run - m), a1 = exp2f(m1 - m); const float inv = 1.f / (l_tot * a0 + l1 * a1);
        const int qi = 32 * wq + l31;
        bf16_t* op = SAMPLE ? (bf16_t*)(ws + WS_OLAT) + (size_t)(b * 16 + (qi & 15)) * 1024 + (qi >> 4) * 256 : (bf16_t*)(ws + WS_YC) + (size_t)(qb * 128 + qi) * 512 + h * 128;
#pragma unroll
        for (int d = 0; d < NDT; ++d)
#pragma unroll
            for (int i4 = 0; i4 < 4; ++i4) { float o[4];
#pragma unroll
                for (int k = 0; k < 4; ++k) o[k] = (Oacc[d][4 * i4 + k] * a0 + e[(d * 16 + 4 * i4 + k) * 64 + lane] * a1) * inv;
                u32x2 wv; wv.x = pk2(o[0], o[1]); wv.y = pk2(o[2], o[3]); *(u32x2*)(op + 32 * d + 8 * i4 + 4 * hh) = wv; }
    }
    lds_barrier();
}

DI void ffn_act(CP c, int l, int bid, int nb) {
    unsigned char* ws = c->ws; const bf16_t* UP = (const bf16_t*)(ws + WS_UP); bf16_t* ACT = (bf16_t*)(ws + WS_ACT);
    const float* cw = c->in[I_FCW] + (size_t)l * 3 * DFF; const float* cb = c->in[I_FCB] + (size_t)l * DFF;
    const int g = bid * 512 + get_tid(); const int ngroups = (nb * 512) / 352; const int rg = g / 352, cc = (g % 352) * 8;
    if (rg >= ngroups) return;
    const int rows_per = (MT + ngroups - 1) / ngroups; const int r0 = rg * rows_per; const int r1 = (r0 + rows_per < MT) ? r0 + rows_per : MT;
    float w0[8], w1[8], w2[8], bb[8], a0[8], a1[8];
#pragma unroll
    for (int j = 0; j < 8; ++j) { w0[j] = cw[cc + j]; w1[j] = cw[DFF + cc + j]; w2[j] = cw[2 * DFF + cc + j]; bb[j] = cb[cc + j]; a0[j] = 0.f; a1[j] = 0.f; }
    for (int r = r0; r < r1; ++r) {
        const bool samp = r >= MP; const int b = (r - MP) >> 4, t = samp ? (r - MP) & 15 : r;
        float a2[8], vv[8], o[8];
        unpack8(*(const u32x4*)(UP + (size_t)r * 5632 + cc), a2); unpack8(*(const u32x4*)(UP + (size_t)r * 5632 + DFF + cc), vv);
        if (r == r0 || (samp && t == 0)) {
            if (t >= 1) unpack8(*(const u32x4*)(UP + (size_t)(r - 1) * 5632 + cc), a1);
            else {
#pragma unroll
                for (int j = 0; j < 8; ++j) a1[j] = samp ? c->in[I_SFFN][((size_t)(l * 32 + b) * 2 + 1) * DFF + cc + j] : 0.f; }
            if (t >= 2) unpack8(*(const u32x4*)(UP + (size_t)(r - 2) * 5632 + cc), a0);
            else {
#pragma unroll
                for (int j = 0; j < 8; ++j) a0[j] = samp ? c->in[I_SFFN][((size_t)(l * 32 + b) * 2 + t) * DFF + cc + j] : 0.f; }
        }
#pragma unroll
        for (int j = 0; j < 8; ++j) { const float y = w0[j] * a0[j] + w1[j] * a1[j] + w2[j] * a2[j] + bb[j]; o[j] = silu(y) * vv[j]; a0[j] = a1[j]; a1[j] = a2[j]; }
        *(u32x4*)(ACT + (size_t)r * DFF + cc) = pack8(o);
        float* so = nullptr;
        if (!samp && r >= MP - 2) so = c->out + O_PFFN + ((size_t)l * 2 + (r - (MP - 2))) * DFF + cc;
        if (samp && t >= 14) so = c->out + O_SFFN + ((size_t)(l * 32 + b) * 2 + (t - 14)) * DFF + cc;
        if (so) {
#pragma unroll
            for (int j = 0; j < 8; ++j) so[j] = a2[j]; }
    }
}

#define XB_TMO      128
#define XB_XCNT(j)  (256  + 64 * (j))
#define XB_XSUB(j)  (1280 + 64 * (j))
#define XB_XGEN(j)  (2304 + 64 * (j))
#define XB_TOP      3328
#define XB_TOPGEN   3392
#define XB_SPIN_CAP (1u << 20)
DI unsigned xb_ld(unsigned* p) { return __hip_atomic_load(p, __ATOMIC_RELAXED, __HIP_MEMORY_SCOPE_AGENT); }
DI unsigned xb_add(unsigned* p, unsigned v) { return __hip_atomic_fetch_add(p, v, __ATOMIC_RELAXED, __HIP_MEMORY_SCOPE_AGENT); }
DI unsigned xb_xcc_id() { return (unsigned)__builtin_amdgcn_s_getreg((3 << 11) | 20) & 0xFu; }
#define XB_SPIN(cond, bar) do { unsigned _sp = 0; while (cond) { __builtin_amdgcn_s_sleep(1); \
    if ((++_sp & 255u) == 0u) { if (xb_ld(&(bar)[XB_TMO])) break; if (_sp > XB_SPIN_CAP) { atomicAdd(&(bar)[XB_TMO], 1u); break; } } } } while (0)
DI void xcd_barrier(unsigned* bar, unsigned x, volatile LAS unsigned* st, unsigned G) {
    asm volatile("s_waitcnt vmcnt(0)" ::: "memory");
    __syncthreads();
    if (get_tid() == 0) {
        __builtin_amdgcn_s_waitcnt(0);
        unsigned nloc = st[0], nx = st[1];
        if (nloc == 0u) {
            unsigned sum, cnt, mine, sp = 0u;
            for (;;) { sum = 0u; cnt = 0u; mine = 0u;
#pragma unroll
                for (unsigned j = 0; j < 16; ++j) { const unsigned cj = xb_ld(&bar[XB_XCNT(j)]); sum += cj; cnt += (cj > 0u) ? 1u : 0u; mine = (j == x) ? cj : mine; }
                if (sum == G) break;
                __builtin_amdgcn_s_sleep(1);
                if ((++sp & 255u) == 0u) { if (xb_ld(&bar[XB_TMO])) break; if (sp > XB_SPIN_CAP) { atomicAdd(&bar[XB_TMO], 1u); break; } } }
            nloc = mine > 0u ? mine : 1u; nx = cnt > 0u ? cnt : 1u; st[0] = nloc; st[1] = nx; }
        const unsigned old = xb_add(&bar[XB_XSUB(x)], 1u);
        const unsigned gen = old / nloc;
        if (old + 1u == (gen + 1u) * nloc) {
            __builtin_amdgcn_fence(__ATOMIC_RELEASE, "agent");
            asm volatile("s_waitcnt vmcnt(0)" ::: "memory");
            const unsigned og = xb_add(&bar[XB_TOP], 1u);
            const unsigned tg = og / nx;
            if (og + 1u == (tg + 1u) * nx) xb_add(&bar[XB_TOPGEN], 1u);
            else XB_SPIN(xb_ld(&bar[XB_TOPGEN]) == tg, bar);
            __builtin_amdgcn_fence(__ATOMIC_ACQUIRE, "agent");
            xb_add(&bar[XB_XGEN(x)], 1u);
            asm volatile("s_waitcnt vmcnt(0)" ::: "memory");
        } else {
            XB_SPIN(xb_ld(&bar[XB_XGEN(x)]) == gen, bar);
            __builtin_amdgcn_fence(__ATOMIC_ACQUIRE, "agent");
            asm volatile("s_waitcnt vmcnt(0)" ::: "memory");
        }
    }
    __syncthreads();
}

DI void grid_barrier(unsigned* ctr, unsigned target) {
    __syncthreads();
    if (get_tid() == 0) {
        __builtin_amdgcn_fence(__ATOMIC_RELEASE, "agent");
        asm volatile("s_waitcnt vmcnt(0) lgkmcnt(0)" ::: "memory");
        __hip_atomic_fetch_add(ctr, 1u, __ATOMIC_RELAXED, __HIP_MEMORY_SCOPE_AGENT);
        while (__hip_atomic_load(ctr, __ATOMIC_RELAXED, __HIP_MEMORY_SCOPE_AGENT) < target) __builtin_amdgcn_s_sleep(2);
        __builtin_amdgcn_fence(__ATOMIC_ACQUIRE, "agent");
        asm volatile("s_waitcnt vmcnt(0) lgkmcnt(0)" ::: "memory");
    }
    __syncthreads();
}

DI int gemm_job_count(int ph) {
    if (ph == 1) return 1;
    if (ph < 3) return 0;
    const int sub = (ph - 3) % NSUB;
    if (sub == 0) return 1; if (sub == 2) return 4; if (sub == 5) return 6; if (sub == 6) return 1; if (sub == 8) return 1; if (sub == 10) return 1;
    return 0;
}
DI GemmJob make_job(CP c, int ph, int j) {
    unsigned char* ws = c->ws; GemmJob J; J.split = 1 << 30; J.o2 = nullptr; J.ld2 = 0; J.f1 = nullptr; J.row0 = 0; J.flag = 0; J.cstart = 0;
    const float* MOD = (const float*)(ws + WS_MOD);
    if (ph == 1) { J.A = (const bf16_t*)(ws + WS_SC); J.Bt = (const bf16_t*)(ws + WS_WADA); J.M = 256; J.N = 12288; J.K = 1024; J.lda = 1024; J.ldb = 1024; J.mode = 0;
        J.o1 = (void*)(ws + WS_MOD); J.ld1 = 12288; J.f1 = c->in[I_BADA]; J.flag = 64; return J; }
    const int l = (ph - 3) / NSUB, sub = (ph - 3) % NSUB;
    if (sub == 0) { J.A = (const bf16_t*)(ws + WS_H); J.Bt = (const bf16_t*)(ws + WS_WIN); J.M = MT; J.N = NIN; J.K = 1024; J.lda = 1024; J.ldb = 1024; J.mode = 1;
        J.o1 = ws + WS_Z1; J.ld1 = NZ1; J.o2 = ws + WS_G; J.ld2 = NG; J.split = NZ1; }
    else if (sub == 2) {
        J.mode = 1;
        if (j == 0) { J.A = (const bf16_t*)(ws + WS_QN); J.Bt = (const bf16_t*)(ws + WS_WUQ); J.M = MT; J.N = 768; J.K = 384; J.lda = 384; J.ldb = 384; J.o1 = ws + WS_Q; J.ld1 = 768; }
        else if (j == 1) { J.A = (const bf16_t*)(ws + WS_LAT); J.Bt = (const bf16_t*)(ws + WS_WUK); J.M = MP; J.N = 512; J.K = 256; J.lda = 256; J.ldb = 256; J.o1 = ws + WS_KN; J.ld1 = 512; }
        else if (j == 2) { J.A = (const bf16_t*)(ws + WS_WUV); J.Bt = (const bf16_t*)(ws + WS_LAT); J.M = 512; J.N = MP; J.K = 256; J.lda = 256; J.ldb = 256; J.o1 = ws + WS_VT; J.ld1 = MP; }
        else { J.A = (const bf16_t*)(ws + WS_QN) + (size_t)MP * 384; J.Bt = (const bf16_t*)(ws + WS_WQABS); J.M = MS; J.N = 1024; J.K = 384; J.lda = 384; J.ldb = 384; J.o1 = ws + WS_QABS; J.ld1 = 1024; }
        J.cstart = (j == 0) ? 0 : (j == 1 ? 206 : (j == 2 ? 78 : 198));
    } else if (sub == 5) {
        const int i = j >> 1, sp = j & 1; const size_t r0 = sp ? MP : 0; J.mode = 2; J.M = sp ? MS : MP; J.N = 1024; J.flag = (i == 0);
        J.o1 = (bf16_t*)(ws + WS_MG) + r0 * 1024; J.ld1 = 1024; J.o2 = (bf16_t*)(ws + WS_G) + r0 * NG + i * 1024; J.ld2 = NG;
        if (i == 2 && sp) { J.A = (const bf16_t*)(ws + WS_OLAT); J.Bt = (const bf16_t*)(ws + WS_WBRC); J.K = 1024; J.lda = 1024; J.ldb = 1024; }
        else { J.A = (const bf16_t*)(ws + (i == 0 ? WS_YA : (i == 1 ? WS_YB : WS_YC))) + r0 * 512; J.Bt = (const bf16_t*)(ws + WS_WBR) + (size_t)i * 1024 * 512; J.K = 512; J.lda = 512; J.ldb = 512; }
    } else if (sub == 6) { J.A = (const bf16_t*)(ws + WS_MG); J.Bt = (const bf16_t*)(ws + WS_WOUT); J.M = MT; J.N = 1024; J.K = 1024; J.lda = 1024; J.ldb = 1024; J.mode = 3;
        J.o1 = ws + WS_XB; J.ld1 = 1024; J.f1 = MOD + l * 6144 + 2 * 1024; }
    else if (sub == 8) { J.A = (const bf16_t*)(ws + WS_H); J.Bt = (const bf16_t*)(ws + WS_WUP); J.M = MT; J.N = 5632; J.K = 1024; J.lda = 1024; J.ldb = 1024; J.mode = 1; J.o1 = ws + WS_UP; J.ld1 = 5632; }
    else { J.A = (const bf16_t*)(ws + WS_ACT); J.Bt = (const bf16_t*)(ws + WS_WDN); J.M = MT; J.N = 1024; J.K = DFF; J.lda = DFF; J.ldb = DFF; J.mode = 3;
        J.o1 = ws + WS_XB; J.ld1 = 1024; J.f1 = MOD + l * 6144 + 5 * 1024; }
    return J;
}

__global__ void __launch_bounds__(512) fwd_megakernel(Ctx carg) {
    extern __shared__ __attribute__((aligned(16))) unsigned char smem[];
    cg::grid_group grid = cg::this_grid();
    const int bid = blockIdx.x, nb = gridDim.x;
    CP c0 = (CP)__builtin_amdgcn_kernarg_segment_ptr();
    int nbar = 0;
    volatile LAS unsigned* xst = (volatile LAS unsigned*)((LAS unsigned char*)smem + LDS_MISC + 64);
    const unsigned xcc = xb_xcc_id();
    if (threadIdx.x == 0) { xst[0] = 0u; xst[1] = 0u; (void)xb_add((unsigned*)(carg.ws + WS_CTL) + XB_XCNT(xcc), 1u); }
    __syncthreads();
    for (int ph = carg.ph_lo; ph < carg.ph_hi; ++ph) {
      const int nrep = (PROBE_DUP >= 0 && ((PROBE_DUP == 100 && ph == 0) || (ph >= 3 && (ph - 3) % NSUB == PROBE_DUP))) ? 2 : 1;
      for (int rep = 0; rep < nrep; ++rep) {
        CP c = c0; asm volatile("" : "+s"(c));
        const int tid = get_tid(), lane = tid & 63, wave = tid >> 6;
        unsigned char* ws = c->ws; const float* MOD = (const float*)(ws + WS_MOD);
        const int njobs = gemm_job_count(ph);
        for (int j = 0; j < njobs; ++j) { const GemmJob J = make_job(c, ph, j); gemm_phase((LAS unsigned char*)smem, J, nb, (nb == 256) ? ((bid + 256 - J.cstart) & 255) : bid); }
        if (ph == 0) { convert_weights(c, 0, (float*)smem, bid, nb, 7); prep_once(c, (float*)smem, bid, nb); }
        else if (ph == 1) { const int skip = (nb > 96) ? 48 : 0;
            if (bid >= skip) ln_pass(c, 0, c->in[I_LN0G], c->in[I_LN0B], nullptr, nullptr, bid - skip, nb - skip, false); }
        else if (ph == 2) { ln_pass(c, 1, nullptr, nullptr, MOD + 1024, MOD, bid, nb, false); }
        else {
            const int l = (ph - 3) / NSUB, sub = (ph - 3) % NSUB;
            if (l == 0 && bid >= 8 && sub == 5) convert_weights(c, 1, (float*)smem, bid - 8, nb - 8, 1);
            if (l == 0 && bid >= 8 && sub == 10) convert_weights(c, 1, (float*)smem, bid - 8, nb - 8, 2);
            if (sub == 1) {
                for (int it = bid; it < NITEM_GDN; it += nb) gdn_chunk(c, l, it, (float*)smem);
                for (int it = (nb == 256) ? ((bid + 128) & 255) : bid; it < 544; it += nb) conva_tile(c, l, it, (float*)smem);
                for (int b = 0; b < 32; ++b) transpose_cvt(c->in[I_CLAT] + ((size_t)(l * 32 + b) * 2048) * 256, 2048, 256, 256, (bf16_t*)(ws + WS_LATT) + (size_t)b * 256 * LTS, LTS, (float*)smem, (bid + 8 * b) % nb, nb);
                for (int i = bid * 512 + tid; i < 32 * 256 * 6; i += nb * 512) { const int row = i / 6, s = i % 6; *(u32x4*)((bf16_t*)(ws + WS_LATT) + (size_t)row * LTS + 2064 + s * 8) = (u32x4){0u, 0u, 0u, 0u}; }
                for (int r = bid * 8 + wave; r < MT; r += nb * 8) mla_row(c, l, r, lane);
            } else if (sub == 3) {
                unsigned* qctr = (unsigned*)(ws + WS_CTL) + 16 + l + 2 * rep; volatile int* sitem = (volatile int*)(smem + LDS_MISC);
                if (bid < 12) gdn_scan(c, l, 0, bid & 3, 1 + (bid >> 2), smem);
                for (;;) {
                    lds_barrier();
                    if (tid == 0) *sitem = (int)atomicAdd(qctr, 1u);
                    lds_barrier();
                    const int it = *sitem;
                    if (it >= 128 + 32 + 512) break;
                    if (it < 128) gdn_scan(c, l, 1 + (it >> 2), it & 3, 0, smem);
                    else if (it < 160) attn_item<320, 256, 32, true>(c, l, it - 128, 0, smem);
                    else { const int k = it - 160; attn_item<192, 128, 64, false>(c, l, 127 - (k >> 2), k & 3, smem); }
                }
            } else if (sub == 4) { for (int it = bid; it < NITEM_GDN + 4; it += nb) gdn_out(c, l, it, smem); }
            else if (sub == 7) { ln_pass(c, 2, c->in[I_LN1G] + l * 1024, c->in[I_LN1B] + l * 1024, MOD + l * 6144 + 4 * 1024, MOD + l * 6144 + 3 * 1024, bid, nb, false); }
            else if (sub == 9) { ffn_act(c, l, bid, nb); }
            else if (sub == 11) {
                if (l == 0) { ln_pass(c, 2, c->in[I_LN2G], c->in[I_LN2B], MOD + 6144 + 1024, MOD + 6144, bid, nb, false); convert_weights(c, 1, (float*)smem, bid, nb, 4); }
                else ln_pass(c, 2, c->in[I_LN2G] + 1024, c->in[I_LN2B] + 1024, nullptr, nullptr, bid, nb, true);
            }
        }
        if (ph + 1 < carg.ph_hi || rep + 1 < nrep) {
            if (carg.ph_lo < 0) grid.sync();
            xcd_barrier((unsigned*)(ws + WS_CTL), xcc, xst, (unsigned)nb);
            ++nbar;
        }
      }
    }
}

extern "C" void kernel_launch(void* const* d_in, const int* in_sizes, int n_in, void* d_out, int out_size, void* d_ws, size_t ws_size, hipStream_t stream) {
    static int grid_blocks = 0;
    if (grid_blocks == 0) {
        if (n_in != N_IN || (size_t)out_size != O_END || ws_size < WS_END) { fprintf(stderr, "kernel_launch: unexpected shapes n_in %d out %d ws %zu (need %zu)\n", n_in, out_size, ws_size, (size_t)WS_END); grid_blocks = -1; return; }
        int dev = 0, cus = 0, per_cu = 0;
        hipGetDevice(&dev); hipDeviceGetAttribute(&cus, hipDeviceAttributeMultiprocessorCount, dev);
        if (hipFuncSetAttribute((const void*)fwd_megakernel, hipFuncAttributeMaxDynamicSharedMemorySize, LDS_BYTES) != hipSuccess) { fprintf(stderr, "kernel_launch: hipFuncSetAttribute failed\n"); grid_blocks = -1; return; }
        hipOccupancyMaxActiveBlocksPerMultiprocessor(&per_cu, (const void*)fwd_megakernel, 512, LDS_BYTES);
        (void)hipGetLastError();
        if (per_cu < 1) per_cu = 1;
        grid_blocks = cus;
    }
    if (grid_blocks < 0) return;
    hipMemsetAsync((char*)d_ws + WS_CTL, 0, WS_CTL_BYTES, stream);
    Ctx c{};
    for (int i = 0; i < N_IN; ++i) c.in[i] = (const float*)d_in[i];
    c.out = (float*)d_out; c.ws = (unsigned char*)d_ws; c.ph_lo = 0; c.ph_hi = NPHASE;
    void* args[] = {&c};
    hipError_t e = hipLaunchCooperativeKernel((const void*)fwd_megakernel, dim3(grid_blocks), dim3(512), args, LDS_BYTES, stream);
    if (e != hipSuccess) fprintf(stderr, "cooperative launch failed: %s (grid %d)\n", hipGetErrorString(e), grid_blocks);
}
```

```cpp
#include <hip/hip_runtime.h>
#include <hip/hip_cooperative_groups.h>
#include <cstdio>
namespace cg = cooperative_groups;

#define DI __device__ __forceinline__
#define LAS __attribute__((address_space(3)))
typedef unsigned short bf16_t;
typedef short bf16x8 __attribute__((ext_vector_type(8)));
typedef short s16x4 __attribute__((ext_vector_type(4)));
typedef float f32x4 __attribute__((ext_vector_type(4)));
typedef float f32x16 __attribute__((ext_vector_type(16)));
typedef unsigned u32x4 __attribute__((ext_vector_type(4)));
typedef unsigned u32x2 __attribute__((ext_vector_type(2)));

constexpr int MP = 16384, MS = 512, MT = MP + MS, DM = 1024, NZ1 = 3840, NG = 3072, NIN = NZ1 + NG, DFF = 2816;
constexpr int NITEM_GDN = 1152;
enum { I_XP = 0, I_XS, I_CLAT, I_CKPE, I_SCA, I_SGC, I_SGDN, I_SFFN, I_CP, I_CS, I_LN0G, I_LN0B, I_WADA, I_BADA, I_WIN, I_CAW, I_CAB,
       I_LNAG, I_LNAB, I_GCW, I_ALOG, I_DTB, I_GNG, I_QNG, I_KVNG, I_WUQ, I_WUKV, I_WBR, I_WOUT, I_LN1G, I_LN1B, I_WUP, I_FCW, I_FCB,
       I_WDN, I_LN2G, I_LN2B, N_IN };
constexpr size_t O_YP = 0, O_YS = O_YP + (size_t)MP * DM, O_PLAT = O_YS + (size_t)MS * DM, O_PKPE = O_PLAT + 2ull * MP * 256,
                 O_PCA = O_PKPE + 2ull * MP * 64, O_PGC = O_PCA + 2ull * 30 * 512, O_PGDN = O_PGC + 2ull * 3 * 1536,
                 O_PFFN = O_PGDN + 2ull * 4 * 16384, O_SLAT = O_PFFN + 2ull * 2 * DFF, O_SKPE = O_SLAT + 2ull * 32 * 16 * 256,
                 O_SCA = O_SKPE + 2ull * 32 * 16 * 64, O_SGC = O_SCA + 2ull * 32 * 30 * 512, O_SGDN = O_SGC + 2ull * 32 * 3 * 1536,
                 O_SFFN = O_SGDN + 2ull * 32 * 4 * 16384, O_END = O_SFFN + 2ull * 32 * 2 * DFF;
constexpr size_t al256(size_t x) { return (x + 255) & ~(size_t)255; }
constexpr size_t WS_CTL = 0, WS_CTL_BYTES = 16384, WS_MOD = WS_CTL_BYTES, WS_SC = WS_MOD + 64ull * 12288 * 4, WS_ROPE = WS_SC + 256ull * 1024 * 2,
                 WS_WIN = WS_ROPE + 16384ull * 32 * 8, WS_WUQ = WS_WIN + (size_t)NIN * 1024 * 2, WS_WUK = WS_WUQ + 768ull * 384 * 2,
                 WS_WUV = WS_WUK + 512ull * 256 * 2, WS_WQABS = WS_WUV + 512ull * 256 * 2, WS_WBR = WS_WQABS + 1024ull * 384 * 2,
                 WS_WBRC = WS_WBR + 3ull * 1024 * 512 * 2, WS_WOUT = WS_WBRC + 1024ull * 1024 * 2, WS_WUP = WS_WOUT + 1024ull * 1024 * 2,
                 WS_WDN = WS_WUP + 5632ull * 1024 * 2, WS_AB = WS_WDN + 1024ull * 2816 * 2;
constexpr size_t WS_Z1 = WS_AB, WS_G = WS_Z1 + (size_t)MT * NZ1 * 2, WS_UP = WS_AB, WS_WADA = WS_AB;
constexpr size_t WS_Q = WS_AB, WS_KN = WS_Q + (size_t)MT * 768 * 2, WS_VT = WS_KN + (size_t)MP * 512 * 2, WS_QABS = WS_VT + 512ull * MP * 2,
                 WS_YB = WS_QABS + 512ull * 1024 * 2, WS_YC = WS_YB + (size_t)MT * 512 * 2, WS_OLAT = WS_YC + (size_t)MT * 512 * 2,
                 WS_ABUSED = WS_OLAT + 512ull * 1024 * 2;
static_assert(WS_ABUSED <= WS_G, "region A overflow");
constexpr size_t WS_C = WS_G + (size_t)MT * NG * 2;
constexpr size_t WS_QN = WS_C, WS_LAT = WS_QN + (size_t)MT * 384 * 2, WS_KPE = WS_LAT + (size_t)MT * 256 * 2, WS_YA = WS_KPE + (size_t)MT * 64 * 2,
                 WS_SZ = WS_YA + (size_t)MT * 512 * 2, WS_U = WS_SZ + (size_t)MT * 512 * 2, WS_W = WS_U + (size_t)NITEM_GDN * 64 * 128 * 2,
                 WS_QD = WS_W + (size_t)NITEM_GDN * 64 * 128 * 2, WS_KDT = WS_QD + (size_t)NITEM_GDN * 64 * 128 * 2,
                 WS_QK = WS_KDT + (size_t)NITEM_GDN * 64 * 128 * 2, WS_EGL = WS_QK + (size_t)NITEM_GDN * 64 * 64 * 2, WS_CEND = WS_EGL + 8192;
constexpr size_t WS_H = WS_YA, WS_ACT = WS_C, WS_MG = WS_U;
constexpr size_t WS_SNP = WS_ABUSED, WS_SNS = WS_QN;
static_assert(WS_SNP + 1024ull * 32768 <= WS_G, "Sn prompt overflow");
static_assert(128ull * 32768 <= (size_t)MT * 384 * 2, "Sn sample overflow");
static_assert((size_t)MT * DFF * 2 <= WS_CEND - WS_C, "ACT overflow");
static_assert((size_t)MT * 5632 * 2 <= WS_C - WS_AB, "UP overflow");
constexpr int LTS = 2112;
constexpr size_t WS_LATT = WS_CEND, WS_XTRA = WS_LATT + 32ull * 256 * LTS * 2, WS_END = WS_XTRA + 72ull * 1024 * 1024;
constexpr size_t WS_XA = WS_XTRA, WS_XA256 = WS_XA + 512ull * 32768, WS_XS128 = WS_XA256 + 4ull * 32768;
constexpr size_t WS_XB = WS_XS128 + 4ull * 32768;
static_assert(WS_XB + (size_t)MT * 1024 * 2 <= WS_END, "XB overflow");
constexpr int LDS_BYTES = 160 * 1024;
constexpr int LDS_MISC = LDS_BYTES - 256;
constexpr int NSUB = 12;
constexpr int NPHASE = 3 + NSUB * 2;
constexpr float DN_ALPHA = 1.4142135623730951f;

#ifndef PROBE_DUP
#define PROBE_DUP (-1)
#endif
struct Ctx { const float* in[N_IN]; float* out; unsigned char* ws; int ph_lo, ph_hi; };
typedef const __attribute__((address_space(4))) Ctx* CP;

DI float bf2f(bf16_t b) { return __uint_as_float(((unsigned)b) << 16); }
DI bf16_t f2bf(float f) { unsigned u = __float_as_uint(f); u += 0x7FFFu + ((u >> 16) & 1u); return (bf16_t)(u >> 16); }
typedef __bf16 hwbf2_t __attribute__((ext_vector_type(2)));
typedef float hwf2_t __attribute__((ext_vector_type(2)));
DI unsigned pk2(float lo, float hi) { const hwf2_t v = {lo, hi}; const hwbf2_t b = __builtin_convertvector(v, hwbf2_t); return __builtin_bit_cast(unsigned, b); }
DI float lo16(unsigned w) { return __uint_as_float(w << 16); }
DI float hi16(unsigned w) { return __uint_as_float(w & 0xffff0000u); }
DI void unpack8(u32x4 w, float* v) { v[0] = lo16(w.x); v[1] = hi16(w.x); v[2] = lo16(w.y); v[3] = hi16(w.y); v[4] = lo16(w.z); v[5] = hi16(w.z); v[6] = lo16(w.w); v[7] = hi16(w.w); }
DI u32x4 pack8(const float* v) { u32x4 w; w.x = pk2(v[0], v[1]); w.y = pk2(v[2], v[3]); w.z = pk2(v[4], v[5]); w.w = pk2(v[6], v[7]); return w; }
DI float wave_sum(float v) { for (int o = 32; o >= 1; o >>= 1) v += __shfl_xor(v, o); return v; }
DI float fexp(float x) { return __builtin_amdgcn_exp2f(x * 1.4426950408889634f); }
DI float sigm(float x) { return __builtin_amdgcn_rcpf(1.f + fexp(-x)); }
DI float silu(float x) { return x * __builtin_amdgcn_rcpf(1.f + fexp(-x)); }
DI int get_tid() { int t = (int)threadIdx.x; asm volatile("" : "+v"(t)); return t; }
DI void lds_barrier() { asm volatile("s_waitcnt lgkmcnt(0)" ::: "memory"); __builtin_amdgcn_s_barrier(); asm volatile("" ::: "memory"); }
DI int modrow_of(int r) { return r < MP ? 0 : 1 + ((r - MP) >> 4); }

namespace pg8 {
constexpr int BM = 256, BK = 64, HALF = 128, HTB = HALF * BK * 2, NXCD = 8, WGM = 8;
__host__ __device__ __forceinline__ int lds_byte(int r, int c) { const int st = (r >> 4) * 2 + (c >> 5), rr = r & 15, cc = c & 31, ob = rr * 64 + cc * 2; return st * 1024 + (ob ^ (((ob >> 9) & 1) << 5)); }
__host__ __device__ __forceinline__ void stage_rc(int b, int& R, int& C) { const int st = b / 1024, sb = b % 1024, swz = sb ^ (((sb >> 9) & 1) << 5); R = (st >> 1) * 16 + swz / 64; C = (st & 1) * 32 + (swz % 64) / 2; }
__host__ __device__ __forceinline__ int perm32(int rho) { const int n = rho >> 4, i = rho & 15; return 8 * (i >> 2) + 4 * n + (i & 3); }
struct Unit { int pm, pn; };
struct StaticOrder {
    int nM, nN, nwg, G, c;
    __device__ void init(int M, int N, int G_, int c_) { nM = M / BM; nN = N / BM; nwg = nM * nN; G = G_; c = c_; }
    __device__ bool next(int i, Unit& u) const {
        const long L = (long)i * G + c; if (L >= nwg) return false;
        int wgid = (int)L; { const int q = nwg / NXCD, r = nwg % NXCD, xcd = wgid % NXCD, off = wgid / NXCD; wgid = (xcd < r ? xcd * (q + 1) : r * (q + 1) + (xcd - r) * q) + off; }
        const int nig = WGM * nN, gid = wgid / nig, fm = gid * WGM, gsz = (nM - fm) < WGM ? (nM - fm) : WGM;
        u.pm = fm + ((wgid % nig) % gsz); u.pn = (wgid % nig) / gsz; return true;
    }
};
}

struct GemmJob { const bf16_t* A; const bf16_t* Bt; int M, N, K, lda, ldb, mode; void* o1; int ld1; void* o2; int ld2; int split; const float* f1; int row0; int flag; int cstart; };

DI void gemm_epilogue(const GemmJob& J, const f32x4 (&acc)[2][2][4][2], const pg8::Unit& u, int wr, int wc, int fr, int fq) {
    const int rloc0 = u.pm * 256 + wr * 64 + fr;
    if (J.mode == 0) {
        float* C = (float*)J.o1; const int col0 = u.pn * 256 + wc * 32 + 4 * fq;
#pragma unroll
        for (int ai = 0; ai < 2; ++ai)
#pragma unroll
            for (int m = 0; m < 4; ++m) { const int row = rloc0 + ai * 128 + m * 16;
                if (row < J.flag) {
#pragma unroll
                    for (int bj = 0; bj < 2; ++bj)
#pragma unroll
                        for (int n = 0; n < 2; ++n) { const int col = col0 + bj * 128 + n * 16; const f32x4 b = *(const f32x4*)(J.f1 + col);
                            *(f32x4*)(C + (size_t)row * J.ld1 + col) = acc[ai][bj][m][n] + b; } }
                asm volatile("" ::: "memory"); }
    } else if (J.mode == 1) {
        int colt = u.pn * 256; bf16_t* base = (bf16_t*)J.o1; int ld = J.ld1;
        if (colt >= J.split) { base = (bf16_t*)J.o2; ld = J.ld2; colt -= J.split; }
        const int col0 = colt + wc * 32 + 8 * fq;
#pragma unroll
        for (int ai = 0; ai < 2; ++ai)
#pragma unroll
            for (int m = 0; m < 4; ++m) { bf16_t* rowp = base + (size_t)(rloc0 + ai * 128 + m * 16) * ld + col0;
#pragma unroll
                for (int bj = 0; bj < 2; ++bj) { const f32x4 v0 = acc[ai][bj][m][0], v1 = acc[ai][bj][m][1];
                    u32x4 w; w.x = pk2(v0[0], v0[1]); w.y = pk2(v0[2], v0[3]); w.z = pk2(v1[0], v1[1]); w.w = pk2(v1[2], v1[3]);
                    *(u32x4*)(rowp + bj * 128) = w; }
                asm volatile("" ::: "memory"); }
    } else if (J.mode == 2) {
        bf16_t* MG = (bf16_t*)J.o1; const bf16_t* Gt = (const bf16_t*)J.o2; const int col0 = u.pn * 256 + wc * 32 + 8 * fq;
        u32x4 gb[2][2], pb[2][2];
#pragma unroll
        for (int bj = 0; bj < 2; ++bj) { gb[0][bj] = *(const u32x4*)(Gt + (size_t)rloc0 * J.ld2 + col0 + bj * 128); pb[0][bj] = (u32x4){0u, 0u, 0u, 0u};
            if (!J.flag) pb[0][bj] = *(const u32x4*)(MG + (size_t)rloc0 * J.ld1 + col0 + bj * 128); }
#pragma unroll
        for (int it = 0; it < 8; ++it) { const int ai = it >> 2, m = it & 3; const int row = rloc0 + ai * 128 + m * 16;
            if (it + 1 < 8) { const int rown = rloc0 + ((it + 1) >> 2) * 128 + ((it + 1) & 3) * 16;
#pragma unroll
                for (int bj = 0; bj < 2; ++bj) { gb[(it + 1) & 1][bj] = *(const u32x4*)(Gt + (size_t)rown * J.ld2 + col0 + bj * 128); pb[(it + 1) & 1][bj] = (u32x4){0u, 0u, 0u, 0u};
                    if (!J.flag) pb[(it + 1) & 1][bj] = *(const u32x4*)(MG + (size_t)rown * J.ld1 + col0 + bj * 128); } }
            __builtin_amdgcn_sched_barrier(0);
#pragma unroll
            for (int bj = 0; bj < 2; ++bj) { float g[8], p[8], a[8]; unpack8(gb[it & 1][bj], g); unpack8(pb[it & 1][bj], p);
                const f32x4 v0 = acc[ai][bj][m][0], v1 = acc[ai][bj][m][1];
                a[0] = v0[0]; a[1] = v0[1]; a[2] = v0[2]; a[3] = v0[3]; a[4] = v1[0]; a[5] = v1[1]; a[6] = v1[2]; a[7] = v1[3];
#pragma unroll
                for (int j = 0; j < 8; ++j) a[j] = a[j] * sigm(g[j]) + p[j];
                *(u32x4*)(MG + (size_t)row * J.ld1 + col0 + bj * 128) = pack8(a); }
            __builtin_amdgcn_sched_barrier(0); }
    } else {
        bf16_t* X = (bf16_t*)J.o1;
        u32x2 xb[2][4]; f32x4 gg[2][4];
        { const float* gp = J.f1 + (size_t)modrow_of(J.row0 + rloc0) * 12288;
#pragma unroll
          for (int q = 0; q < 4; ++q) { const int col = u.pn * 256 + (q >> 1) * 128 + wc * 32 + (q & 1) * 16 + 4 * fq; xb[0][q] = *(const u32x2*)(X + (size_t)rloc0 * J.ld1 + col); gg[0][q] = *(const f32x4*)(gp + col); } }
#pragma unroll
        for (int it = 0; it < 8; ++it) { const int ai = it >> 2, m = it & 3; const int row = rloc0 + ai * 128 + m * 16;
            if (it + 1 < 8) { const int rown = rloc0 + ((it + 1) >> 2) * 128 + ((it + 1) & 3) * 16; const float* gp = J.f1 + (size_t)modrow_of(J.row0 + rown) * 12288;
#pragma unroll
                for (int q = 0; q < 4; ++q) { const int col = u.pn * 256 + (q >> 1) * 128 + wc * 32 + (q & 1) * 16 + 4 * fq; xb[(it + 1) & 1][q] = *(const u32x2*)(X + (size_t)rown * J.ld1 + col); gg[(it + 1) & 1][q] = *(const f32x4*)(gp + col); } }
            __builtin_amdgcn_sched_barrier(0);
#pragma unroll
            for (int q = 0; q < 4; ++q) { const int bj = q >> 1, n = q & 1; const int col = u.pn * 256 + bj * 128 + wc * 32 + n * 16 + 4 * fq;
                const u32x2 xw = xb[it & 1][q]; const f32x4 xv = (f32x4){lo16(xw.x), hi16(xw.x), lo16(xw.y), hi16(xw.y)};
                const f32x4 o = xv * DN_ALPHA + (gg[it & 1][q] + 1.0f) * acc[ai][bj][m][n];
                u32x2 w; w.x = pk2(o[0], o[1]); w.y = pk2(o[2], o[3]); *(u32x2*)(X + (size_t)row * J.ld1 + col) = w; }
            __builtin_amdgcn_sched_barrier(0); }
    }
}

DI void gemm_phase(LAS unsigned char* lds, const GemmJob& g, int G, int cidx) {
    using namespace pg8;
    const int tid = get_tid(), wid = __builtin_amdgcn_readfirstlane(tid >> 6), lane = tid & 63, wr = wid >> 2, wc = wid & 3, fr = lane & 15, fq = lane >> 4;
    const int nt = g.K / BK;
    StaticOrder S; S.init(g.M, g.N, G, cidx);
    const bool perm = (g.mode == 1 || g.mode == 2);
    unsigned voffA[2], voffB[2];
#pragma unroll
    for (int i = 0; i < 2; ++i) { int R, C; stage_rc(tid * 16 + i * 8192, R, C); const int Rb = perm ? ((R & ~31) + perm32(R & 31)) : R;
        voffA[i] = (unsigned)(R * g.lda + C) * 2u; voffB[i] = (unsigned)(Rb * g.ldb + C) * 2u; }
    const size_t kstep = (size_t)(BK * 2);
    const size_t hstepA = (size_t)HALF * g.lda * 2, hstepB = (size_t)HALF * g.ldb * 2;
    const size_t tstepA = 2 * hstepA, tstepB = 2 * hstepB;
    const unsigned ldsw = (unsigned)wid * 1024u;
    const int aoff = lds_byte(wr * 64 + fr, fq * 8), boff = lds_byte(wc * 32 + fr, fq * 8);
#define PG8_SA(b, h) (((b) * 2 + (h)) * HTB)
#define PG8_SB(b, h) ((4 + (b) * 2 + (h)) * HTB)
#define PG8_STAGE(bufoff, gbase, voff) do { _Pragma("unroll") for (int _i = 0; _i < 2; ++_i) \
        __builtin_amdgcn_global_load_lds((const unsigned*)((const char*)(gbase) + (voff)[_i]), (LAS unsigned*)(lds + (bufoff) + ldsw + _i * 8192), 16, 0, 0); } while (0)
#define PG8_LDA(dst, b, h) do { _Pragma("unroll") for (int m = 0; m < 4; ++m) _Pragma("unroll") for (int k = 0; k < 2; ++k) dst[m][k] = *(const LAS bf16x8*)(lds + PG8_SA(b, h) + aoff + m * 2048 + k * 1024); } while (0)
#define PG8_LDB(dst, b, h) do { _Pragma("unroll") for (int n = 0; n < 2; ++n) _Pragma("unroll") for (int k = 0; k < 2; ++k) dst[n][k] = *(const LAS bf16x8*)(lds + PG8_SB(b, h) + boff + n * 2048 + k * 1024); } while (0)
#define PG8_MMA(ai, bj, At, Bt) do { __builtin_amdgcn_s_setprio(1); _Pragma("unroll") for (int m = 0; m < 4; ++m) _Pragma("unroll") for (int n = 0; n < 2; ++n) _Pragma("unroll") for (int k = 0; k < 2; ++k) \
        acc[ai][bj][m][n] = __builtin_amdgcn_mfma_f32_16x16x32_bf16(Bt[n][k], At[m][k], acc[ai][bj][m][n], 0, 0, 0); __builtin_amdgcn_s_setprio(0); } while (0)
#define PG8_WAIT_V(n) asm volatile("s_waitcnt vmcnt(" #n ")" ::: "memory")
#define PG8_WAIT_L(n) asm volatile("s_waitcnt lgkmcnt(" #n ")" ::: "memory")
#define PG8_BAR __builtin_amdgcn_s_barrier()
#define PG8_SCHED __builtin_amdgcn_sched_barrier(0)
    Unit cur, nxt; int ui = 0;
    if (!S.next(0, cur)) return;
    f32x4 acc[2][2][4][2];
#pragma unroll
    for (int a = 0; a < 2; ++a)
#pragma unroll
        for (int b = 0; b < 2; ++b)
#pragma unroll
            for (int m = 0; m < 4; ++m)
#pragma unroll
                for (int n = 0; n < 2; ++n) acc[a][b][m][n] = (f32x4){0.f, 0.f, 0.f, 0.f};
    bf16x8 At[4][2], B0[2][2], B1[2][2];
    const char* cA = (const char*)g.A + (size_t)cur.pm * tstepA; const char* cB = (const char*)g.Bt + (size_t)cur.pn * tstepB;
    PG8_STAGE(PG8_SB(0, 0), cB, voffB); PG8_STAGE(PG8_SA(0, 0), cA, voffA); PG8_STAGE(PG8_SB(0, 1), cB + hstepB, voffB); PG8_STAGE(PG8_SA(0, 1), cA + hstepA, voffA);
    if (wr == 1) PG8_BAR;
    PG8_WAIT_V(4); PG8_BAR;
    PG8_STAGE(PG8_SB(1, 0), cB + kstep, voffB); PG8_STAGE(PG8_SA(1, 0), cA + kstep, voffA); PG8_STAGE(PG8_SB(1, 1), cB + hstepB + kstep, voffB);
    PG8_WAIT_V(6); PG8_BAR;
    for (;;) {
        const bool has_next = S.next(ui + 1, nxt);
        const char* nA = has_next ? (const char*)g.A + (size_t)nxt.pm * tstepA : cA; const char* nB = has_next ? (const char*)g.Bt + (size_t)nxt.pn * tstepB : cB;
        for (int t = 0; t < nt; t += 2) {
            const bool last = (t == nt - 2);
            const char* a1 = cA + (size_t)(t + 1) * kstep;
            const char* a2 = last ? nA : cA + (size_t)(t + 2) * kstep; const char* b2 = last ? nB : cB + (size_t)(t + 2) * kstep;
            const char* a3 = a2 + kstep; const char* b3 = b2 + kstep;
            PG8_LDB(B0, 0, 0); PG8_SCHED; PG8_LDA(At, 0, 0); PG8_STAGE(PG8_SA(1, 1), a1 + hstepA, voffA);
            PG8_WAIT_L(8); PG8_BAR; PG8_WAIT_L(0); PG8_MMA(0, 0, At, B0); PG8_BAR; PG8_SCHED;
            PG8_LDB(B1, 0, 1); PG8_STAGE(PG8_SB(0, 0), b2, voffB);
            PG8_BAR; PG8_WAIT_L(0); PG8_MMA(0, 1, At, B1); PG8_BAR;
            PG8_LDA(At, 0, 1); PG8_STAGE(PG8_SA(0, 0), a2, voffA);
            PG8_BAR; PG8_WAIT_L(0); PG8_MMA(1, 0, At, B0); PG8_BAR; PG8_SCHED;
            PG8_STAGE(PG8_SB(0, 1), b2 + hstepB, voffB);
            PG8_WAIT_V(6); PG8_BAR; PG8_MMA(1, 1, At, B1); PG8_BAR;
            PG8_LDB(B0, 1, 0); PG8_SCHED; PG8_LDA(At, 1, 0); PG8_STAGE(PG8_SA(0, 1), a2 + hstepA, voffA);
            PG8_WAIT_L(8); PG8_BAR; PG8_WAIT_L(0); PG8_MMA(0, 0, At, B0); PG8_BAR; PG8_SCHED;
            PG8_LDB(B1, 1, 1); PG8_STAGE(PG8_SB(1, 0), b3, voffB);
            PG8_BAR; PG8_WAIT_L(0); PG8_MMA(0, 1, At, B1); PG8_BAR;
            PG8_LDA(At, 1, 1); PG8_STAGE(PG8_SA(1, 0), a3, voffA);
            PG8_BAR; PG8_WAIT_L(0); PG8_MMA(1, 0, At, B0); PG8_BAR; PG8_SCHED;
            PG8_STAGE(PG8_SB(1, 1), b3 + hstepB, voffB);
            PG8_WAIT_V(6); PG8_BAR; PG8_MMA(1, 1, At, B1); PG8_BAR;
        }
        gemm_epilogue(g, acc, cur, wr, wc, fr, fq);
        if (!has_next) break;
#pragma unroll
        for (int a = 0; a < 2; ++a)
#pragma unroll
            for (int b = 0; b < 2; ++b)
#pragma unroll
                for (int m = 0; m < 4; ++m)
#pragma unroll
                    for (int n = 0; n < 2; ++n) acc[a][b][m][n] = (f32x4){0.f, 0.f, 0.f, 0.f};
        cur = nxt; cA = nA; cB = nB; ++ui;
    }
    PG8_WAIT_V(0);
    if (wr == 0) PG8_BAR;
    PG8_BAR;
#undef PG8_SA
#undef PG8_SB
#undef PG8_STAGE
#undef PG8_LDA
#undef PG8_LDB
#undef PG8_MMA
#undef PG8_WAIT_V
#undef PG8_WAIT_L
#undef PG8_BAR
#undef PG8_SCHED
}

DI void transpose_cvt(const float* src, int K, int N, int lds_src, bf16_t* dst, int ldd, float* tile, int bid, int nb) {
    const int tid = get_tid(); const int tk = K / 64, tn = (N + 63) / 64, T = tk * tn;
    const int kk0 = tid >> 4, n4 = (tid & 15) * 4;
    f32x4 c0 = (f32x4){0.f, 0.f, 0.f, 0.f}, c1 = c0;
    if (bid < T) { const int k0 = (bid % tk) * 64, n0 = (bid / tk) * 64;
        if (n0 + n4 < N) { c0 = *(const f32x4*)(src + (size_t)(k0 + kk0) * lds_src + n0 + n4); c1 = *(const f32x4*)(src + (size_t)(k0 + kk0 + 32) * lds_src + n0 + n4); } }
    for (int t = bid; t < T; t += nb) {
        const int k0 = (t % tk) * 64, n0 = (t / tk) * 64;
        tile[kk0 * 65 + n4] = c0[0]; tile[kk0 * 65 + n4 + 1] = c0[1]; tile[kk0 * 65 + n4 + 2] = c0[2]; tile[kk0 * 65 + n4 + 3] = c0[3];
        tile[(kk0 + 32) * 65 + n4] = c1[0]; tile[(kk0 + 32) * 65 + n4 + 1] = c1[1]; tile[(kk0 + 32) * 65 + n4 + 2] = c1[2]; tile[(kk0 + 32) * 65 + n4 + 3] = c1[3];
        f32x4 d0 = (f32x4){0.f, 0.f, 0.f, 0.f}, d1 = d0;
        { const int t2 = t + nb;
          if (t2 < T) { const int k2 = (t2 % tk) * 64, n2 = (t2 / tk) * 64;
              if (n2 + n4 < N) { d0 = *(const f32x4*)(src + (size_t)(k2 + kk0) * lds_src + n2 + n4); d1 = *(const f32x4*)(src + (size_t)(k2 + kk0 + 32) * lds_src + n2 + n4); } } }
        lds_barrier();
        { const int nn = tid >> 3, k8 = (tid & 7) * 8; float v[8];
#pragma unroll
            for (int j = 0; j < 8; ++j) v[j] = tile[(k8 + j) * 65 + nn];
            if (n0 + nn < N) *(u32x4*)(dst + (size_t)(n0 + nn) * ldd + k0 + k8) = pack8(v); }
        lds_barrier();
        c0 = d0; c1 = d1;
    }
}

DI void convert_weights(CP c, int l, float* tile, int bid, int nb, int mask) {
    unsigned char* ws = c->ws; const int tid = get_tid();
    const float* wukv = c->in[I_WUKV] + (size_t)l * 256 * 1024;
    if (mask & 1) {
        bf16_t* WinT = (bf16_t*)(ws + WS_WIN);
        const float* w_in = c->in[I_WIN] + (size_t)l * 1024 * 6856;
        transpose_cvt(w_in, 1024, 3784, 6856, WinT, 1024, tile, bid, nb);
        transpose_cvt(w_in + 3784, 1024, 3072, 6856, WinT + (size_t)NZ1 * 1024, 1024, tile, (bid + 64) % nb, nb);
        for (int i = bid * 512 + tid; i < 56 * 1024 / 8; i += nb * 512) *(u32x4*)(WinT + (size_t)3784 * 1024 + (size_t)i * 8) = (u32x4){0u, 0u, 0u, 0u};
        transpose_cvt(c->in[I_WUQ] + (size_t)l * 384 * 768, 384, 768, 768, (bf16_t*)(ws + WS_WUQ), 384, tile, (bid + 160) % nb, nb);
        for (int h = 0; h < 4; ++h) {
            transpose_cvt(wukv + h * 256, 256, 128, 1024, (bf16_t*)(ws + WS_WUK) + (size_t)h * 128 * 256, 256, tile, (bid + 200 + 16 * h) % nb, nb);
            transpose_cvt(wukv + h * 256 + 128, 256, 128, 1024, (bf16_t*)(ws + WS_WUV) + (size_t)h * 128 * 256, 256, tile, (bid + 208 + 16 * h) % nb, nb);
        }
        { const float* wuq = c->in[I_WUQ] + (size_t)l * 384 * 768; bf16_t* dst = (bf16_t*)(ws + WS_WQABS);
          for (int o = bid * 512 + tid; o < 1024 * 384; o += nb * 512) { const int n = o / 384, k = o % 384, h = n >> 8, j = n & 255;
              const f32x4* a = (const f32x4*)(wukv + (size_t)j * 1024 + h * 256); const f32x4* b = (const f32x4*)(wuq + (size_t)k * 768 + h * 192); float s = 0.f;
#pragma unroll 8
              for (int d = 0; d < 32; ++d) { const f32x4 x = a[d], y = b[d]; s += x[0] * y[0] + x[1] * y[1] + x[2] * y[2] + x[3] * y[3]; }
              dst[o] = f2bf(s); } }
    }
    if (mask & 2) {
        transpose_cvt(c->in[I_WUP] + (size_t)l * 1024 * 5632, 1024, 5632, 5632, (bf16_t*)(ws + WS_WUP), 1024, tile, (bid + 128) % nb, nb);
        transpose_cvt(c->in[I_WOUT] + (size_t)l * 1024 * 1024, 1024, 1024, 1024, (bf16_t*)(ws + WS_WOUT), 1024, tile, (bid + 32) % nb, nb);
        for (int i = 0; i < 3; ++i)
            transpose_cvt(c->in[I_WBR] + (size_t)(l * 3 + i) * 512 * 1024, 512, 1024, 1024, (bf16_t*)(ws + WS_WBR) + (size_t)i * 1024 * 512, 512, tile, (bid + 96 + 40 * i) % nb, nb);
        { const float* wb = c->in[I_WBR] + (size_t)(l * 3 + 2) * 512 * 1024; bf16_t* dst = (bf16_t*)(ws + WS_WBRC);
          for (int o = bid * 512 + tid; o < 1024 * 256; o += nb * 512) { const int k = o >> 8, n = (o & 255) * 4, h = k >> 8, j = k & 255;
              const float* a = wukv + (size_t)j * 1024 + h * 256 + 128; const float* b = wb + (size_t)(h * 128) * 1024 + n; f32x4 sacc = (f32x4){0.f, 0.f, 0.f, 0.f};
#pragma unroll 16
              for (int cc = 0; cc < 128; ++cc) sacc += *(const f32x4*)(b + (size_t)cc * 1024) * a[cc];
#pragma unroll
              for (int q = 0; q < 4; ++q) dst[(size_t)(n + q) * 1024 + k] = f2bf(sacc[q]); } }
    }
    if (mask & 4)
        transpose_cvt(c->in[I_WDN] + (size_t)l * 2816 * 1024, 2816, 1024, 1024, (bf16_t*)(ws + WS_WDN), 2816, tile, (bid + 192) % nb, nb);
}

DI void prep_once(CP c, float* tile, int bid, int nb) {
    unsigned char* ws = c->ws; const int tid = get_tid();
    for (int l = 0; l < 2; ++l)
        transpose_cvt(c->in[I_WADA] + (size_t)l * 1024 * 6144, 1024, 6144, 6144, (bf16_t*)(ws + WS_WADA) + (size_t)l * 6144 * 1024, 1024, tile, (bid + 128 * l) % nb, nb);
    bf16_t* SC = (bf16_t*)(ws + WS_SC);
    for (int i = bid * 512 + tid; i < 256 * 1024; i += nb * 512) { const int r = i >> 10, k = i & 1023; float v = 0.f;
        if (r == 0) v = silu(c->in[I_CP][k]); else if (r <= 32) v = silu(c->in[I_CS][(r - 1) * 1024 + k]);
        SC[i] = f2bf(v); }
    float* rope = (float*)(ws + WS_ROPE);
    for (int i = bid * 512 + tid; i < 16384 * 32; i += nb * 512) { const int pos = i >> 5, f = i & 31;
        const float invf = exp2f(-(float)f * 0.41524101186092029f); const float ang = (float)pos * invf;
        const double a = (double)ang; const double kq = rint(a * 0.15915494309189535); const float rr = (float)(a - kq * 6.283185307179586);
        rope[2 * i] = __cosf(rr); rope[2 * i + 1] = __sinf(rr); }
}

DI void ln_pass(CP c, int mode, const float* gam, const float* bet, const float* modsc, const float* modsh, int bid, int nb, bool fin) {
    const int tid = get_tid(), lane = tid & 63, wave = tid >> 6;
    bf16_t* XB = (bf16_t*)(c->ws + WS_XB); bf16_t* H = (bf16_t*)(c->ws + WS_H);
    for (int r = bid * 8 + wave; r < MT; r += nb * 8) {
        f32x4 v[4];
        if (mode == 0) { const float* src = r < MP ? c->in[I_XP] + (size_t)r * DM : c->in[I_XS] + (size_t)(r - MP) * DM;
#pragma unroll
            for (int i = 0; i < 4; ++i) v[i] = *(const f32x4*)(src + lane * 4 + 256 * i); }
        else {
#pragma unroll
            for (int i = 0; i < 4; ++i) { const u32x2 w = *(const u32x2*)(XB + (size_t)r * DM + lane * 4 + 256 * i); v[i] = (f32x4){lo16(w.x), hi16(w.x), lo16(w.y), hi16(w.y)}; } }
        if (mode != 1) {
            float s = 0.f;
#pragma unroll
            for (int i = 0; i < 4; ++i) s += v[i][0] + v[i][1] + v[i][2] + v[i][3];
            const float mean = wave_sum(s) * (1.f / 1024.f); float q = 0.f;
#pragma unroll
            for (int i = 0; i < 4; ++i) { const f32x4 d = v[i] - mean; q += d[0] * d[0] + d[1] * d[1] + d[2] * d[2] + d[3] * d[3]; }
            const float rstd = rsqrtf(wave_sum(q) * (1.f / 1024.f) + 1e-5f);
#pragma unroll
            for (int i = 0; i < 4; ++i) { const int col = lane * 4 + 256 * i; const f32x4 g = *(const f32x4*)(gam + col), b = *(const f32x4*)(bet + col);
                v[i] = (v[i] - mean) * rstd * g + b;
                if (fin) *(f32x4*)(c->out + (size_t)r * DM + col) = v[i];
                else { u32x2 w; w.x = pk2(v[i][0], v[i][1]); w.y = pk2(v[i][2], v[i][3]); *(u32x2*)(XB + (size_t)r * DM + col) = w; } }
        }
        if (modsc) { const int mr = modrow_of(r);
#pragma unroll
            for (int i = 0; i < 4; ++i) { const int col = lane * 4 + 256 * i; const f32x4 sc = *(const f32x4*)(modsc + (size_t)mr * 12288 + col), sh = *(const f32x4*)(modsh + (size_t)mr * 12288 + col);
                const f32x4 h = v[i] * (sc + 1.0f) + sh; u32x2 w; w.x = pk2(h[0], h[1]); w.y = pk2(h[2], h[3]);
                *(u32x2*)(H + (size_t)r * DM + col) = w; } }
    }
}

DI void mla_row(CP c, int l, int r, int lane) {
    unsigned char* ws = c->ws; const bf16_t* z = (const bf16_t*)(ws + WS_Z1) + (size_t)r * NZ1;
    const bool samp = r >= MP; const int b = (r - MP) >> 4, t = (r - MP) & 15;
    {
        float v[8]; float ss = 0.f;
        if (lane < 48) { unpack8(*(const u32x4*)(z + 3080 + lane * 8), v);
#pragma unroll
            for (int j = 0; j < 8; ++j) ss += v[j] * v[j]; }
        const float rs = rsqrtf(wave_sum(ss) * (1.f / 384.f) + 1e-6f);
        if (lane < 48) { const float* g = c->in[I_QNG] + l * 384 + lane * 8;
#pragma unroll
            for (int j = 0; j < 8; ++j) v[j] = v[j] * rs * g[j];
            *(u32x4*)((bf16_t*)(ws + WS_QN) + (size_t)r * 384 + lane * 8) = pack8(v); }
    }
    {
        float v[8]; float ss = 0.f;
        if (lane < 32) { unpack8(*(const u32x4*)(z + 3464 + lane * 8), v);
#pragma unroll
            for (int j = 0; j < 8; ++j) ss += v[j] * v[j]; }
        const float rs = rsqrtf(wave_sum(ss) * (1.f / 256.f) + 1e-6f);
        if (lane < 32) { const float* g = c->in[I_KVNG] + l * 256 + lane * 8;
#pragma unroll
            for (int j = 0; j < 8; ++j) v[j] = v[j] * rs * g[j];
            *(u32x4*)((bf16_t*)(ws + WS_LAT) + (size_t)r * 256 + lane * 8) = pack8(v);
            float* o = samp ? c->out + O_SLAT + ((size_t)(l * 32 + b) * 16 + t) * 256 + lane * 8 : c->out + O_PLAT + ((size_t)l * MP + r) * 256 + lane * 8;
            *(f32x4*)o = (f32x4){v[0], v[1], v[2], v[3]}; *(f32x4*)(o + 4) = (f32x4){v[4], v[5], v[6], v[7]};
            if (samp) { bf16_t* lt = (bf16_t*)(ws + WS_LATT) + ((size_t)b * 256 + lane * 8) * LTS + 2048 + t;
#pragma unroll
                for (int j = 0; j < 8; ++j) lt[(size_t)j * LTS] = f2bf(v[j]); } }
    }
    if (lane < 32) {
        const float x1 = bf2f(z[3720 + lane]), x2 = bf2f(z[3752 + lane]); const int pos = samp ? 2048 + t : r;
        const float* cs = (const float*)(ws + WS_ROPE) + ((size_t)pos * 32 + lane) * 2; const float co = cs[0], si = cs[1];
        const float o1 = x1 * co - x2 * si, o2 = x2 * co + x1 * si;
        bf16_t* kp = (bf16_t*)(ws + WS_KPE) + (size_t)r * 64; kp[lane] = f2bf(o1); kp[32 + lane] = f2bf(o2);
        float* o = samp ? c->out + O_SKPE + ((size_t)(l * 32 + b) * 16 + t) * 64 : c->out + O_PKPE + ((size_t)l * MP + r) * 64;
        o[lane] = o1; o[32 + lane] = o2;
    }
    {
        float v[8]; unpack8(*(const u32x4*)(z + 2560 + lane * 8), v);
#pragma unroll
        for (int j = 0; j < 8; ++j) v[j] = silu(v[j]);
        *(u32x4*)((bf16_t*)(ws + WS_SZ) + (size_t)r * 512 + lane * 8) = pack8(v);
    }
    float* gco = nullptr;
    if (!samp && r >= MP - 3) gco = c->out + O_PGC + ((size_t)l * 3 + (r - (MP - 3))) * 1536;
    if (samp && t >= 13) gco = c->out + O_SGC + ((size_t)(l * 32 + b) * 3 + (t - 13)) * 1536;
    if (gco) for (int i = 0; i < 24; ++i) gco[lane + 64 * i] = bf2f(z[1024 + lane + 64 * i]);
}

DI void conva_tile(CP c, int l, int tile, float* U) {
    unsigned char* ws = c->ws; const int tid = get_tid(), ch = tid, lane = tid & 63, wave = tid >> 6;
    const bool samp = tile >= 512; const int b = tile - 512; const int RT = samp ? 16 : 32; const int t0 = samp ? 0 : tile * 32; const int rbase = samp ? MP + b * 16 : 0;
    const bf16_t* Z1 = (const bf16_t*)(ws + WS_Z1);
#pragma unroll 4
    for (int v = tid; v < (RT + 30) * 64; v += 512) { const int i = v >> 6, c8 = (v & 63) * 8; const int t = t0 - 30 + i; float u[8];
        if (t < 0) {
            if (samp) { const float* hp = c->in[I_SCA] + ((size_t)(l * 32 + b) * 30 + (30 + t)) * 512 + c8; const f32x4 a = *(const f32x4*)hp, bq = *(const f32x4*)(hp + 4);
                u[0] = a[0]; u[1] = a[1]; u[2] = a[2]; u[3] = a[3]; u[4] = bq[0]; u[5] = bq[1]; u[6] = bq[2]; u[7] = bq[3]; }
            else {
#pragma unroll
                for (int j = 0; j < 8; ++j) u[j] = 0.f; }
        } else { const bf16_t* z = Z1 + (size_t)(rbase + t) * NZ1 + c8; float a[8], gt[8]; unpack8(*(const u32x4*)z, a); unpack8(*(const u32x4*)(z + 512), gt);
#pragma unroll
            for (int j = 0; j < 8; ++j) u[j] = a[j] * sigm(gt[j]); }
        *(f32x4*)(U + i * 512 + c8) = (f32x4){u[0], u[1], u[2], u[3]}; *(f32x4*)(U + i * 512 + c8 + 4) = (f32x4){u[4], u[5], u[6], u[7]}; }
    lds_barrier();
    if (samp) { for (int j = 0; j < 30; ++j) c->out[O_SCA + ((size_t)(l * 32 + b) * 30 + j) * 512 + ch] = U[(16 + j) * 512 + ch]; }
    else if (tile == 511) { for (int j = 0; j < 30; ++j) c->out[O_PCA + ((size_t)l * 30 + j) * 512 + ch] = U[(32 + j) * 512 + ch]; }
    float w[31];
#pragma unroll
    for (int i = 0; i < 31; ++i) w[i] = c->in[I_CAW][((size_t)l * 31 + i) * 512 + ch];
    const float bias = c->in[I_CAB][l * 512 + ch];
#pragma unroll 1
    for (int tt = 0; tt < RT; ++tt) { float acc = bias;
#pragma unroll
        for (int i = 0; i < 31; ++i) acc += w[i] * U[(tt + i) * 512 + ch];
        U[tt * 512 + ch] = acc; }
    lds_barrier();
    {
        float v[4][8], sm[4], qv[4];
#pragma unroll
        for (int k = 0; k < 4; ++k) { const int tt = wave + 8 * k; sm[k] = 0.f;
            if (tt < RT) { const f32x4 a = *(const f32x4*)(U + tt * 512 + lane * 8), bq = *(const f32x4*)(U + tt * 512 + lane * 8 + 4);
                v[k][0] = a[0]; v[k][1] = a[1]; v[k][2] = a[2]; v[k][3] = a[3]; v[k][4] = bq[0]; v[k][5] = bq[1]; v[k][6] = bq[2]; v[k][7] = bq[3]; }
            else {
#pragma unroll
                for (int j = 0; j < 8; ++j) v[k][j] = 0.f; }
#pragma unroll
            for (int j = 0; j < 8; ++j) sm[k] += v[k][j]; }
#pragma unroll
        for (int o = 32; o >= 1; o >>= 1)
#pragma unroll
            for (int k = 0; k < 4; ++k) sm[k] += __shfl_xor(sm[k], o);
#pragma unroll
        for (int k = 0; k < 4; ++k) { sm[k] *= (1.f / 512.f); qv[k] = 0.f;
#pragma unroll
            for (int j = 0; j < 8; ++j) { const float d = v[k][j] - sm[k]; qv[k] += d * d; } }
#pragma unroll
        for (int o = 32; o >= 1; o >>= 1)
#pragma unroll
            for (int k = 0; k < 4; ++k) qv[k] += __shfl_xor(qv[k], o);
        const float* g = c->in[I_LNAG] + l * 512 + lane * 8; const float* be = c->in[I_LNAB] + l * 512 + lane * 8;
#pragma unroll
        for (int k = 0; k < 4; ++k) { const int tt = wave + 8 * k;
            if (tt < RT) { const float rstd = rsqrtf(qv[k] * (1.f / 512.f) + 1e-5f); float o8[8];
#pragma unroll
                for (int j = 0; j < 8; ++j) o8[j] = silu((v[k][j] - sm[k]) * rstd * g[j] + be[j]);
                *(u32x4*)((bf16_t*)(ws + WS_YA) + (size_t)(rbase + t0 + tt) * 512 + lane * 8) = pack8(o8); } }
    }
    lds_barrier();
}

DI void gdn_chunk(CP c, int l, int item, float* sm) {
    unsigned char* ws = c->ws; const int tid = get_tid(), lane = tid & 63, wave = tid >> 6;
    float* Qs = sm; float* Ks = Qs + 64 * 132; float* R = Ks + 64 * 132; float* Ls = R + 64 * 260; float* gs = Ls + 64 * 68; float* bs = gs + 64;
    const bool samp = item >= 1024; const int h = item & 3; const int n = item >> 2; const int b = (item - 1024) >> 2;
    const int C = samp ? 16 : 64; const int rbase = samp ? MP + b * 16 : n * 64;
    const bf16_t* Z1 = (const bf16_t*)(ws + WS_Z1);
    if (tid < 384) {
        const int part = tid >> 7, cc = tid & 127, col = part * 512 + h * 128 + cc;
        const float* cw = c->in[I_GCW] + (size_t)l * 4 * 1536 + col; const float w0 = cw[0], w1 = cw[1536], w2 = cw[2 * 1536], w3 = cw[3 * 1536];
        float x0 = 0.f, x1 = 0.f, x2 = 0.f;
        if (samp) { const float* hs = c->in[I_SGC] + (size_t)(l * 32 + b) * 3 * 1536 + col; x0 = hs[0]; x1 = hs[1536]; x2 = hs[2 * 1536]; }
        else if (n > 0) { const bf16_t* zz = Z1 + (size_t)(rbase - 3) * NZ1 + 1024 + col; x0 = bf2f(zz[0]); x1 = bf2f(zz[NZ1]); x2 = bf2f(zz[2 * NZ1]); }
        float* dst = part == 0 ? Qs + cc : (part == 1 ? Ks + cc : R + cc); const int dstride = part == 2 ? 260 : 132;
        const bf16_t* zr = Z1 + (size_t)rbase * NZ1 + 1024 + col;
#pragma unroll 1
        for (int i0 = 0; i0 < 64; i0 += 32) {
            unsigned xr[32];
#pragma unroll
            for (int k = 0; k < 32; ++k) xr[k] = (i0 + k < C) ? (unsigned)zr[(size_t)(i0 + k) * NZ1] : 0u;
#pragma unroll
            for (int k = 0; k < 32; ++k) { float y = 0.f;
                if (i0 + k < C) { const float x3 = lo16(xr[k]); y = silu(w0 * x0 + w1 * x1 + w2 * x2 + w3 * x3); x0 = x1; x1 = x2; x2 = x3; }
                dst[(i0 + k) * dstride] = y; }
        }
    }
    if (wave == 7) {
        float beta = 0.f, g = 0.f;
        if (lane < C) { const bf16_t* z = Z1 + (size_t)(rbase + lane) * NZ1; beta = sigm(bf2f(z[3072 + h]));
            const float x = bf2f(z[3076 + h]) + c->in[I_DTB][l * 4 + h]; const float sp = fmaxf(x, 0.f) + log1pf(expf(-fabsf(x)));
            g = -expf(c->in[I_ALOG][l * 4 + h]) * sp; }
        for (int o = 1; o < 64; o <<= 1) { const float tv = __shfl_up(g, o); if (lane >= o) g += tv; }
        gs[lane] = g; bs[lane] = beta;
    }
    lds_barrier();
    {
        float* rows = (wave < 4) ? Qs + (wave * 16) * 132 : Ks + ((wave - 4) * 16) * 132; const float qsc = (wave < 4) ? 0.08838834764831845f : 1.f;
        float av[16], bv[16], ssv[16];
#pragma unroll
        for (int k = 0; k < 16; ++k) { av[k] = rows[k * 132 + lane]; bv[k] = rows[k * 132 + 64 + lane]; ssv[k] = av[k] * av[k] + bv[k] * bv[k]; }
#pragma unroll
        for (int o = 32; o >= 1; o >>= 1)
#pragma unroll
            for (int k = 0; k < 16; ++k) ssv[k] += __shfl_xor(ssv[k], o);
#pragma unroll
        for (int k = 0; k < 16; ++k) { const float sc = rsqrtf(ssv[k] + 1e-6f) * qsc; rows[k * 132 + lane] = av[k] * sc; rows[k * 132 + 64 + lane] = bv[k] * sc; }
    }
    lds_barrier();
    {
        const int i = tid >> 3, t7 = tid & 7; float kk[8], qk[8];
#pragma unroll
        for (int j = 0; j < 8; ++j) { kk[j] = 0.f; qk[j] = 0.f; }
        const int wv = __builtin_amdgcn_readfirstlane(wave); const int njj = (8 * wv < C) ? wv + 1 : 0;
        if (njj > 0) {
            for (int d4 = 0; d4 < 32; ++d4) { const f32x4 ki = *(const f32x4*)(Ks + i * 132 + d4 * 4), qi = *(const f32x4*)(Qs + i * 132 + d4 * 4);
#pragma unroll
                for (int jj = 0; jj < 8; ++jj) if (jj < njj) { const f32x4 kj = *(const f32x4*)(Ks + (t7 + 8 * jj) * 132 + d4 * 4);
                    kk[jj] += ki[0] * kj[0] + ki[1] * kj[1] + ki[2] * kj[2] + ki[3] * kj[3]; qk[jj] += qi[0] * kj[0] + qi[1] * kj[1] + qi[2] * kj[2] + qi[3] * kj[3]; } }
        }
        const float gi = gs[i], bi = bs[i]; bf16_t* qkrow = (bf16_t*)(ws + WS_QK) + ((size_t)item * 64 + i) * 64;
#pragma unroll
        for (int jj = 0; jj < 8; ++jj) { const int j = t7 + 8 * jj; const float dec = (j <= i) ? __expf(gi - gs[j]) : 0.f;
            Ls[j * 68 + i] = (j < i) ? bi * kk[jj] * dec : 0.f; qkrow[j] = f2bf((j <= i) ? qk[jj] * dec : 0.f); }
    }
    for (int e = tid; e < 64 * 128; e += 512) { const int i = e >> 7, cc = e & 127; const float bi = bs[i];
        R[i * 260 + cc] *= bi; R[i * 260 + 128 + cc] = Ks[i * 132 + cc] * bi * __expf(gs[i]); }
    lds_barrier();
    if (tid < 256) {
        const int col = tid;
#pragma unroll
        for (int i0 = 0; i0 < 64; i0 += 8) {
            if (i0 >= C) break;
            float acc[8];
#pragma unroll
            for (int r = 0; r < 8; ++r) acc[r] = R[(i0 + r) * 260 + col];
#pragma unroll 8
            for (int j = 0; j < i0; ++j) { const float xj = R[j * 260 + col]; const f32x4 la = *(const f32x4*)(Ls + j * 68 + i0), lb = *(const f32x4*)(Ls + j * 68 + i0 + 4);
                acc[0] -= la[0] * xj; acc[1] -= la[1] * xj; acc[2] -= la[2] * xj; acc[3] -= la[3] * xj;
                acc[4] -= lb[0] * xj; acc[5] -= lb[1] * xj; acc[6] -= lb[2] * xj; acc[7] -= lb[3] * xj; }
#pragma unroll
            for (int r = 1; r < 8; ++r)
#pragma unroll
                for (int r2 = 0; r2 < r; ++r2) acc[r] -= Ls[(i0 + r2) * 68 + i0 + r] * acc[r2];
#pragma unroll
            for (int r = 0; r < 8; ++r) R[(i0 + r) * 260 + col] = acc[r];
        }
    } else {
        const int t2 = tid - 256; const float glast = gs[63];
        for (int v = t2; v < 1024; v += 256) { const int i = v >> 4, c8 = (v & 15) * 8; const float e = __expf(gs[i]); float o[8];
#pragma unroll
            for (int j = 0; j < 8; ++j) o[j] = Qs[i * 132 + c8 + j] * e;
            *(u32x4*)((bf16_t*)(ws + WS_QD) + ((size_t)item * 64 + i) * 128 + c8) = pack8(o); }
        for (int v = t2; v < 1024; v += 256) { const int cc = v >> 3, i8 = (v & 7) * 8; float o[8];
#pragma unroll
            for (int j = 0; j < 8; ++j) o[j] = Ks[(i8 + j) * 132 + cc] * __expf(glast - gs[i8 + j]);
            *(u32x4*)((bf16_t*)(ws + WS_KDT) + ((size_t)item * 128 + cc) * 64 + i8) = pack8(o); }
        if (t2 == 0) ((float*)(ws + WS_EGL))[item] = __expf(glast);
    }
    lds_barrier();
    for (int v = tid; v < 2048; v += 512) { const int i = v >> 5, c8 = (v & 31) * 8; float o[8];
#pragma unroll
        for (int j = 0; j < 8; ++j) o[j] = R[i * 260 + c8 + j];
        bf16_t* dst = c8 < 128 ? (bf16_t*)(ws + WS_U) + ((size_t)item * 64 + i) * 128 + c8 : (bf16_t*)(ws + WS_W) + ((size_t)item * 64 + i) * 128 + (c8 - 128);
        *(u32x4*)dst = pack8(o); }
    lds_barrier();
}

DI void gdn_scan(CP c, int l, int seq, int h, int mode, unsigned char* sm) {
    unsigned char* ws = c->ws; const int tid = get_tid(), lane = tid & 63, w = tid >> 6, fr = lane & 15, fq = lane >> 4;
    bf16_t* Wt = (bf16_t*)sm;
    bf16_t* KDt = Wt + 2 * 64 * 136;
    bf16_t* VTs = KDt + 2 * 128 * 72;
    bf16_t* STs = VTs + 128 * 72;
    bf16_t* Ut = STs + 128 * 136;
    const bool samp = seq > 0; const int b = seq - 1; const int nsteps = samp ? 1 : 128; const bool amode = (mode == 3); const float uscale = amode ? 0.f : 1.f;
    const int n0 = (mode >= 2) ? 128 : 0;
    const int item0 = samp ? 1024 + b * 4 + h : h + 4 * n0;
    const bf16_t* Ug = (const bf16_t*)(ws + WS_U); const bf16_t* Wg = (const bf16_t*)(ws + WS_W);
    const bf16_t* KDTg = (const bf16_t*)(ws + WS_KDT); const float* EGL = (const float*)(ws + WS_EGL);
    bf16_t* SNg = samp ? (bf16_t*)(ws + WS_SNS) + (size_t)(b * 4 + h) * 16384 : (amode ? (bf16_t*)(ws + WS_XA) + (size_t)h * 16384 : (bf16_t*)(ws + WS_SNP) + (size_t)(h + 4 * n0) * 16384);
    float* sout = samp ? c->out + O_SGDN + ((size_t)(l * 32 + b) * 4 + h) * 16384 : c->out + O_PGDN + ((size_t)l * 4 + h) * 16384;
    f32x4 Sacc[8];
#pragma unroll
    for (int mt = 0; mt < 8; ++mt) {
        if (samp) { const float* sp = c->in[I_SGDN] + ((size_t)(l * 32 + b) * 4 + h) * 16384;
#pragma unroll
            for (int i = 0; i < 4; ++i) Sacc[mt][i] = sp[(16 * mt + 4 * fq + i) * 128 + 16 * w + fr]; }
        else {
#pragma unroll
            for (int i = 0; i < 4; ++i) Sacc[mt][i] = (amode && (16 * mt + 4 * fq + i == 16 * w + fr)) ? 1.f : 0.f; }
    }
    const u32x4 z4 = (u32x4){0u, 0u, 0u, 0u};
    u32x4 Pw0 = z4, Pw1 = z4, Pk0 = z4, Pk1 = z4, Qw0 = z4, Qw1 = z4, Qk0 = z4, Qk1 = z4, Pu0 = z4, Pu1 = z4, Qu0 = z4, Qu1 = z4; float Pe = 1.f, Qe = 1.f, egl = 1.f;
#define SC_ISSUE(X, it) do { const size_t _i = (size_t)(it); \
        X##w0 = *(const u32x4*)(Wg + _i * 8192 + (size_t)tid * 8); X##w1 = *(const u32x4*)(Wg + _i * 8192 + (size_t)(tid + 512) * 8); \
        X##k0 = *(const u32x4*)(KDTg + _i * 8192 + (size_t)tid * 8); X##k1 = *(const u32x4*)(KDTg + _i * 8192 + (size_t)(tid + 512) * 8); \
        X##u0 = *(const u32x4*)(Ug + _i * 8192 + (size_t)tid * 8); X##u1 = *(const u32x4*)(Ug + _i * 8192 + (size_t)(tid + 512) * 8); \
        X##e = EGL[_i]; } while (0)
#define SC_COMMIT(X, buf) do { bf16_t* _W = Wt + (buf) * 64 * 136; bf16_t* _K = KDt + (buf) * 128 * 72; bf16_t* _U = Ut + (buf) * 64 * 136; \
        { const int v = tid, r = v >> 4, sg = (v & 15) * 8; *(u32x4*)(_W + r * 136 + sg) = X##w0; *(u32x4*)(_U + r * 136 + sg) = X##u0; } \
        { const int v = tid + 512, r = v >> 4, sg = (v & 15) * 8; *(u32x4*)(_W + r * 136 + sg) = X##w1; *(u32x4*)(_U + r * 136 + sg) = X##u1; } \
        { const int v = tid, r = v >> 3, sg = (v & 7) * 8; *(u32x4*)(_K + r * 72 + sg) = X##k0; } \
        { const int v = tid + 512, r = v >> 3, sg = (v & 7) * 8; *(u32x4*)(_K + r * 72 + sg) = X##k1; } \
        egl = X##e; } while (0)
#define SC_STEP(X, n) do { const int _n = (n); const int _buf = _n & 1; const bf16_t* _W = Wt + _buf * 64 * 136; const bf16_t* _K = KDt + _buf * 128 * 72; const bf16_t* _U = Ut + _buf * 64 * 136; \
        bf16_t* _sn = SNg + (size_t)_n * 4 * 16384; \
        _Pragma("unroll") for (int mt = 0; mt < 8; ++mt) { u32x2 p; p.x = pk2(Sacc[mt][0], Sacc[mt][1]); p.y = pk2(Sacc[mt][2], Sacc[mt][3]); \
            *(u32x2*)(STs + (16 * w + fr) * 136 + 16 * mt + 4 * fq) = p; \
            if (!amode) *(u32x2*)(_sn + (size_t)(16 * w + fr) * 128 + 16 * mt + 4 * fq) = p; \
            else { bf16_t* _q = _sn + (size_t)(16 * mt + 4 * fq) * 128 + 16 * w + fr; _q[0] = (bf16_t)(p.x & 0xffffu); _q[128] = (bf16_t)(p.x >> 16); _q[256] = (bf16_t)(p.y & 0xffffu); _q[384] = (bf16_t)(p.y >> 16); } } \
        asm volatile("s_waitcnt lgkmcnt(0)" ::: "memory"); __builtin_amdgcn_wave_barrier(); \
        bf16x8 Sb[4]; bf16x8 Af[8]; bf16_t ucur[16]; \
        _Pragma("unroll") for (int mt = 0; mt < 4; ++mt) _Pragma("unroll") for (int i = 0; i < 4; ++i) ucur[mt * 4 + i] = _U[(16 * mt + 4 * fq + i) * 136 + 16 * w + fr]; \
        _Pragma("unroll") for (int s_ = 0; s_ < 4; ++s_) Sb[s_] = *(const bf16x8*)(STs + (16 * w + fr) * 136 + 32 * s_ + 8 * fq); \
        _Pragma("unroll") for (int hb = 0; hb < 2; ++hb) { \
            _Pragma("unroll") for (int m2 = 0; m2 < 2; ++m2) _Pragma("unroll") for (int s_ = 0; s_ < 4; ++s_) Af[m2 * 4 + s_] = *(const bf16x8*)(_W + (16 * (2 * hb + m2) + fr) * 136 + 32 * s_ + 8 * fq); \
            __builtin_amdgcn_sched_barrier(0); \
            _Pragma("unroll") for (int m2 = 0; m2 < 2; ++m2) { const int mt = 2 * hb + m2; f32x4 a = (f32x4){0.f, 0.f, 0.f, 0.f}; \
                _Pragma("unroll") for (int s_ = 0; s_ < 4; ++s_) a = __builtin_amdgcn_mfma_f32_16x16x32_bf16(Af[m2 * 4 + s_], Sb[s_], a, 0, 0, 0); \
                u32x2 p; p.x = pk2(uscale * bf2f(ucur[mt * 4 + 0]) - a[0], uscale * bf2f(ucur[mt * 4 + 1]) - a[1]); p.y = pk2(uscale * bf2f(ucur[mt * 4 + 2]) - a[2], uscale * bf2f(ucur[mt * 4 + 3]) - a[3]); \
                *(u32x2*)(VTs + (16 * w + fr) * 72 + 16 * mt + 4 * fq) = p; } \
            __builtin_amdgcn_sched_barrier(0); } \
        _Pragma("unroll") for (int m2 = 0; m2 < 4; ++m2) _Pragma("unroll") for (int s_ = 0; s_ < 2; ++s_) Af[m2 * 2 + s_] = *(const bf16x8*)(_K + (16 * m2 + fr) * 72 + 32 * s_ + 8 * fq); \
        asm volatile("s_waitcnt lgkmcnt(0)" ::: "memory"); __builtin_amdgcn_wave_barrier(); \
        bf16x8 Vb[2]; \
        _Pragma("unroll") for (int s_ = 0; s_ < 2; ++s_) Vb[s_] = *(const bf16x8*)(VTs + (16 * w + fr) * 72 + 32 * s_ + 8 * fq); \
        _Pragma("unroll") for (int hb = 0; hb < 2; ++hb) { \
            if (hb == 1) { _Pragma("unroll") for (int m2 = 0; m2 < 4; ++m2) _Pragma("unroll") for (int s_ = 0; s_ < 2; ++s_) Af[m2 * 2 + s_] = *(const bf16x8*)(_K + (16 * (4 + m2) + fr) * 72 + 32 * s_ + 8 * fq); } \
            __builtin_amdgcn_sched_barrier(0); \
            _Pragma("unroll") for (int m2 = 0; m2 < 4; ++m2) { const int mt = 4 * hb + m2; f32x4 a = Sacc[mt] * egl; \
                _Pragma("unroll") for (int s_ = 0; s_ < 2; ++s_) a = __builtin_amdgcn_mfma_f32_16x16x32_bf16(Af[m2 * 2 + s_], Vb[s_], a, 0, 0, 0); \
                Sacc[mt] = a; } \
            __builtin_amdgcn_sched_barrier(0); } \
        SC_COMMIT(X, _buf ^ 1); \
        if (_n + 3 < nsteps) SC_ISSUE(X, item0 + 4 * (_n + 3)); \
        lds_barrier(); } while (0)
    lds_barrier();
    SC_ISSUE(Q, item0); SC_COMMIT(Q, 0);
    if (nsteps > 1) { SC_ISSUE(P, item0 + 4); SC_ISSUE(Q, item0 + 8); }
    lds_barrier();
    for (int n = 0; n < nsteps; n += 2) {
        SC_STEP(P, n);
        if (n + 1 < nsteps) SC_STEP(Q, n + 1);
    }
#undef SC_ISSUE
#undef SC_COMMIT
#undef SC_STEP
    if (mode == 0 || mode == 2) {
#pragma unroll
        for (int mt = 0; mt < 8; ++mt)
#pragma unroll
            for (int i = 0; i < 4; ++i) sout[(16 * mt + 4 * fq + i) * 128 + 16 * w + fr] = Sacc[mt][i];
    } else if (mode == 1) {
        bf16_t* x = (bf16_t*)(ws + WS_XS128) + (size_t)h * 16384;
#pragma unroll
        for (int mt = 0; mt < 8; ++mt) { u32x2 p; p.x = pk2(Sacc[mt][0], Sacc[mt][1]); p.y = pk2(Sacc[mt][2], Sacc[mt][3]); *(u32x2*)(x + (size_t)(16 * w + fr) * 128 + 16 * mt + 4 * fq) = p; }
    } else {
        bf16_t* x = (bf16_t*)(ws + WS_XA256) + (size_t)h * 16384;
#pragma unroll
        for (int mt = 0; mt < 8; ++mt)
#pragma unroll
            for (int i = 0; i < 4; ++i) x[(size_t)(16 * mt + 4 * fq + i) * 128 + 16 * w + fr] = f2bf(Sacc[mt][i]);
    }
    lds_barrier();
}

DI void gdn_out(CP c, int l, int item, unsigned char* sm) {
    unsigned char* ws = c->ws; const int tid = get_tid(), lane = tid & 63, w = tid >> 6, fr = lane & 15, fq = lane >> 4;
    bf16_t* Ws = (bf16_t*)sm; bf16_t* QDs = Ws + 64 * 136; bf16_t* QKs = QDs + 64 * 136; bf16_t* VTs = QKs + 64 * 72; bf16_t* STs = VTs + 128 * 72;
    float* OS = (float*)(STs + 128 * 136);
    const bool samp = item >= 1024; const int h = item & 3, n = item >> 2, b = (item - 1024) >> 2; const int C = samp ? 16 : 64;
    const bf16_t* Ug = (const bf16_t*)(ws + WS_U) + (size_t)item * 8192; const bf16_t* Wg = (const bf16_t*)(ws + WS_W) + (size_t)item * 8192;
    const bf16_t* QDg = (const bf16_t*)(ws + WS_QD) + (size_t)item * 8192; const bf16_t* QKg = (const bf16_t*)(ws + WS_QK) + (size_t)item * 4096;
    const bf16_t* SNg = samp ? (const bf16_t*)(ws + WS_SNS) + (size_t)(item - 1024) * 16384 : (const bf16_t*)(ws + WS_SNP) + (size_t)item * 16384;
    const bool fin = item >= NITEM_GDN;
    const bool comb = fin || (!samp && n >= 128);
    if (comb) {
        const int hh = fin ? item - NITEM_GDN : h;
        const bf16_t* XAg = fin ? (const bf16_t*)(ws + WS_XA256) + (size_t)hh * 16384 : (const bf16_t*)(ws + WS_XA) + (size_t)((n - 128) * 4 + h) * 16384;
        const bf16_t* XSg = (const bf16_t*)(ws + WS_XS128) + (size_t)hh * 16384;
        bf16_t* As = Ws; bf16_t* S8s = (bf16_t*)OS;
#pragma unroll
        for (int k = 0; k < 4; ++k) { const int v = tid + 512 * k, r = v >> 4, sg = (v & 15) * 8;
            *(u32x4*)(As + r * 136 + sg) = *(const u32x4*)(XAg + (size_t)v * 8); *(u32x4*)(S8s + r * 136 + sg) = *(const u32x4*)(XSg + (size_t)v * 8); }
        lds_barrier();
        bf16x8 Bf[4];
#pragma unroll
        for (int s2 = 0; s2 < 4; ++s2) Bf[s2] = *(const bf16x8*)(S8s + (16 * w + fr) * 136 + 32 * s2 + 8 * fq);
#pragma unroll
        for (int mt = 0; mt < 8; ++mt) { f32x4 a = (f32x4){0.f, 0.f, 0.f, 0.f};
#pragma unroll
            for (int s2 = 0; s2 < 4; ++s2) a = __builtin_amdgcn_mfma_f32_16x16x32_bf16(*(const bf16x8*)(As + (16 * mt + fr) * 136 + 32 * s2 + 8 * fq), Bf[s2], a, 0, 0, 0);
            if (fin) { float* o = c->out + O_PGDN + ((size_t)l * 4 + hh) * 16384;
#pragma unroll
                for (int i = 0; i < 4; ++i) o[(16 * mt + 4 * fq + i) * 128 + 16 * w + fr] += a[i]; }
            else { const u32x2 bb = *(const u32x2*)(SNg + (size_t)(16 * w + fr) * 128 + 16 * mt + 4 * fq);
                u32x2 p; p.x = pk2(a[0] + lo16(bb.x), a[1] + hi16(bb.x)); p.y = pk2(a[2] + lo16(bb.y), a[3] + hi16(bb.y));
                *(u32x2*)(STs + (16 * w + fr) * 136 + 16 * mt + 4 * fq) = p; }
            asm volatile("" ::: "memory"); }
        lds_barrier();
        if (fin) return;
    }
#pragma unroll
    for (int k = 0; k < 2; ++k) { const int v = tid + 512 * k, r = v >> 4, sg = (v & 15) * 8;
        *(u32x4*)(Ws + r * 136 + sg) = *(const u32x4*)(Wg + (size_t)v * 8); *(u32x4*)(QDs + r * 136 + sg) = *(const u32x4*)(QDg + (size_t)v * 8); }
    { const int v = tid, r = v >> 3, sg = (v & 7) * 8; *(u32x4*)(QKs + r * 72 + sg) = *(const u32x4*)(QKg + (size_t)v * 8); }
    if (!comb) {
#pragma unroll
        for (int k = 0; k < 4; ++k) { const int v = tid + 512 * k, r = v >> 4, sg = (v & 15) * 8; *(u32x4*)(STs + r * 136 + sg) = *(const u32x4*)(SNg + (size_t)v * 8); }
    }
    float uu[16];
#pragma unroll
    for (int mt = 0; mt < 4; ++mt)
#pragma unroll
        for (int i = 0; i < 4; ++i) uu[mt * 4 + i] = bf2f(Ug[(size_t)(16 * mt + 4 * fq + i) * 128 + 16 * w + fr]);
    unsigned zg[16];
#pragma unroll
    for (int k = 0; k < 8; ++k) { const int i = w * 8 + k; const int r = samp ? MP + b * 16 + (i < C ? i : 0) : n * 64 + i;
        const bf16_t* sz = (const bf16_t*)(ws + WS_SZ) + (size_t)r * 512 + h * 128; zg[2 * k] = (unsigned)sz[lane]; zg[2 * k + 1] = (unsigned)sz[64 + lane]; }
    lds_barrier();
    bf16x8 Sb[4];
#pragma unroll
    for (int s = 0; s < 4; ++s) Sb[s] = *(const bf16x8*)(STs + (16 * w + fr) * 136 + 32 * s + 8 * fq);
#pragma unroll
    for (int mt = 0; mt < 4; ++mt) { f32x4 a = (f32x4){0.f, 0.f, 0.f, 0.f};
#pragma unroll
        for (int s = 0; s < 4; ++s) a = __builtin_amdgcn_mfma_f32_16x16x32_bf16(*(const bf16x8*)(Ws + (16 * mt + fr) * 136 + 32 * s + 8 * fq), Sb[s], a, 0, 0, 0);
        u32x2 p; p.x = pk2(uu[mt * 4 + 0] - a[0], uu[mt * 4 + 1] - a[1]); p.y = pk2(uu[mt * 4 + 2] - a[2], uu[mt * 4 + 3] - a[3]);
        *(u32x2*)(VTs + (16 * w + fr) * 72 + 16 * mt + 4 * fq) = p; asm volatile("" ::: "memory"); }
    asm volatile("s_waitcnt lgkmcnt(0)" ::: "memory"); __builtin_amdgcn_wave_barrier();
    bf16x8 Vb[2];
#pragma unroll
    for (int s = 0; s < 2; ++s) Vb[s] = *(const bf16x8*)(VTs + (16 * w + fr) * 72 + 32 * s + 8 * fq);
#pragma unroll
    for (int mt = 0; mt < 4; ++mt) { f32x4 o = (f32x4){0.f, 0.f, 0.f, 0.f};
#pragma unroll
        for (int s = 0; s < 4; ++s) o = __builtin_amdgcn_mfma_f32_16x16x32_bf16(*(const bf16x8*)(QDs + (16 * mt + fr) * 136 + 32 * s + 8 * fq), Sb[s], o, 0, 0, 0);
#pragma unroll
        for (int s = 0; s < 2; ++s) o = __builtin_amdgcn_mfma_f32_16x16x32_bf16(*(const bf16x8*)(QKs + (16 * mt + fr) * 72 + 32 * s + 8 * fq), Vb[s], o, 0, 0, 0);
#pragma unroll
        for (int i = 0; i < 4; ++i) OS[(16 * mt + 4 * fq + i) * 132 + 16 * w + fr] = o[i];
        asm volatile("" ::: "memory"); }
    lds_barrier();
    const float gn0 = c->in[I_GNG][l * 128 + lane], gn1 = c->in[I_GNG][l * 128 + 64 + lane];
    if (w * 8 < C) {
        float av[8], bv[8], ssv[8];
#pragma unroll
        for (int k = 0; k < 8; ++k) { const int i = w * 8 + k; av[k] = OS[i * 132 + lane]; bv[k] = OS[i * 132 + 64 + lane]; ssv[k] = av[k] * av[k] + bv[k] * bv[k]; }
#pragma unroll
        for (int o = 32; o >= 1; o >>= 1)
#pragma unroll
            for (int k = 0; k < 8; ++k) ssv[k] += __shfl_xor(ssv[k], o);
#pragma unroll
        for (int k = 0; k < 8; ++k) { const int i = w * 8 + k; const int r = samp ? MP + b * 16 + i : n * 64 + i;
            const float rs = rsqrtf(ssv[k] * (1.f / 128.f) + 1e-6f);
            bf16_t* yb = (bf16_t*)(ws + WS_YB) + (size_t)r * 512 + h * 128;
            yb[lane] = f2bf(av[k] * rs * gn0 * lo16(zg[2 * k])); yb[64 + lane] = f2bf(bv[k] * rs * gn1 * lo16(zg[2 * k + 1])); }
    }
    lds_barrier();
}

template <int DK, int DV, int KT, bool SAMPLE>
DI void attn_item(CP c, int l, int qb, int h, unsigned char* sm) {
    constexpr int NQ = SAMPLE ? 64 : 128, QS = DK + 8, VS = KT + 8, NMT = KT / 32, NDT = DV / 32;
    unsigned char* ws = c->ws; const int tid = get_tid(), lane = tid & 63, w = tid >> 6, g = w >> 2, wq = w & 3, l31 = lane & 31, hh = lane >> 5, gt = tid & 255;
    bf16_t* Qs = (bf16_t*)sm; bf16_t* Ks = Qs + NQ * QS + g * (KT * QS + DV * VS); bf16_t* Vs = Ks + KT * QS;
    float* Ex = (float*)(Qs + NQ * QS);
    const bf16_t* Qg = (const bf16_t*)(ws + WS_Q); const bf16_t* KNg = (const bf16_t*)(ws + WS_KN); const bf16_t* KPEg = (const bf16_t*)(ws + WS_KPE);
    const bf16_t* VTg = (const bf16_t*)(ws + WS_VT); const bf16_t* LATg = (const bf16_t*)(ws + WS_LAT); const bf16_t* LTg = (const bf16_t*)(ws + WS_LATT);
    const float* rope = (const float*)(ws + WS_ROPE);
    const int b = qb;
    lds_barrier();
    if (!SAMPLE) {
        for (int v = tid; v < 128 * 24; v += 512) { const int r = v / 24, s = v % 24; *(u32x4*)(Qs + r * QS + s * 8) = *(const u32x4*)(Qg + (size_t)(qb * 128 + r) * 768 + h * 192 + s * 8); }
    } else {
        const bf16_t* QAg = (const bf16_t*)(ws + WS_QABS);
        for (int v = tid; v < 64 * 40; v += 512) { const int r = v / 40, s = v % 40, hq = r >> 4, t = r & 15;
            const bf16_t* src = s < 32 ? QAg + (size_t)(b * 16 + t) * 1024 + hq * 256 + s * 8 : Qg + (size_t)(MP + b * 16 + t) * 768 + hq * 192 + 128 + (s - 32) * 8;
            *(u32x4*)(Qs + r * QS + s * 8) = *(const u32x4*)src; }
    }
    lds_barrier();
    for (int v = tid; v < NQ * 32; v += 512) { const int r = v >> 5, f = v & 31; const int pos = SAMPLE ? 2048 + (r & 15) : qb * 128 + r;
        const float co = rope[((size_t)pos * 32 + f) * 2], si = rope[((size_t)pos * 32 + f) * 2 + 1];
        bf16_t* q = Qs + r * QS + (DK - 64); const float x1 = bf2f(q[f]), x2 = bf2f(q[32 + f]);
        q[f] = f2bf(x1 * co - x2 * si); q[32 + f] = f2bf(x2 * co + x1 * si); }
    constexpr bool QREG = false;
    bf16x8 Qf[QREG ? DK / 16 : 1];
    if (QREG) { lds_barrier();
#pragma unroll
        for (int ks = 0; ks < (QREG ? DK / 16 : 1); ++ks) Qf[ks] = *(const bf16x8*)(Qs + (32 * wq + l31) * QS + 16 * ks + 8 * hh); }
    const int ntiles = SAMPLE ? 66 : 2 * qb + 2; const int nj = ntiles / 2;
    const bool wave_on = SAMPLE ? (wq < 2) : true;
    const int qc = 2 * qb + (wq >> 1);
    f32x16 Oacc[NDT];
#pragma unroll
    for (int d = 0; d < NDT; ++d)
#pragma unroll
        for (int i = 0; i < 16; ++i) Oacc[d][i] = 0.f;
    float m_run = -INFINITY, l_run = 0.f;
    const float scale = 0.07216878364870322f * 1.4426950408889634f;
    u32x4 kreg[6], vreg[4];
    const int lkey = gt >> 2, ls0 = gt & 3, ldv = gt >> 1, lv0 = gt & 1;
    const bf16_t* kn_base = KNg + (size_t)lkey * 512 + h * 128 + ls0 * 8; const bf16_t* kp_base = KPEg + (size_t)lkey * 64 + ls0 * 8;
    const bf16_t* vt_base = VTg + (size_t)(h * 128 + ldv) * MP + lv0 * 8;
#define ATT_ISSUE(kt) do { const size_t _k0 = (size_t)(kt) * 64; \
        _Pragma("unroll") for (int i = 0; i < 4; ++i) kreg[i] = *(const u32x4*)(kn_base + _k0 * 512 + i * 32); \
        _Pragma("unroll") for (int i = 0; i < 2; ++i) kreg[4 + i] = *(const u32x4*)(kp_base + _k0 * 64 + i * 32); \
        _Pragma("unroll") for (int i = 0; i < 4; ++i) vreg[i] = *(const u32x4*)(vt_base + _k0 + i * 16); } while (0)
    if (!SAMPLE) ATT_ISSUE(g);
    for (int j = 0; j < nj; ++j) {
        const int kt = 2 * j + g;
        lds_barrier();
        if (!SAMPLE) {
#pragma unroll
            for (int i = 0; i < 6; ++i) *(u32x4*)(Ks + lkey * QS + ls0 * 8 + i * 32) = kreg[i];
#pragma unroll
            for (int i = 0; i < 4; ++i) *(u32x4*)(Vs + ldv * VS + lv0 * 8 + i * 16) = vreg[i];
        } else {
            const int k0 = kt * 32;
            for (int v = gt; v < 32 * 40; v += 256) { const int key = v / 40, s = v % 40, kk = k0 + key; u32x4 o = (u32x4){0u, 0u, 0u, 0u};
                if (kk < 2048) { const float* src = s < 32 ? c->in[I_CLAT] + ((size_t)(l * 32 + b) * 2048 + kk) * 256 + s * 8 : c->in[I_CKPE] + ((size_t)(l * 32 + b) * 2048 + kk) * 64 + (s - 32) * 8;
                    const f32x4 a = *(const f32x4*)src, bq = *(const f32x4*)(src + 4); o.x = pk2(a[0], a[1]); o.y = pk2(a[2], a[3]); o.z = pk2(bq[0], bq[1]); o.w = pk2(bq[2], bq[3]); }
                else if (kk < 2064) { const int rr = MP + b * 16 + (kk - 2048); o = *(const u32x4*)(s < 32 ? LATg + (size_t)rr * 256 + s * 8 : KPEg + (size_t)rr * 64 + (s - 32) * 8); }
                *(u32x4*)(Ks + key * QS + s * 8) = o; }
            for (int v = gt; v < 256 * 4; v += 256) { const int dv = v >> 2, s = v & 3; u32x4 o = (u32x4){0u, 0u, 0u, 0u};
                if (k0 < LTS) o = *(const u32x4*)(LTg + ((size_t)b * 256 + dv) * LTS + k0 + s * 8);
                *(u32x4*)(Vs + dv * VS + s * 8) = o; }
        }
        lds_barrier();
        if (!SAMPLE) { if (j + 1 < nj) ATT_ISSUE(kt + 2); }
        const bool active = SAMPLE ? (wave_on && kt * 32 < 2064) : (kt <= qc);
        if (active) {
            f32x16 S[NMT];
#pragma unroll
            for (int mt = 0; mt < NMT; ++mt)
#pragma unroll
                for (int i = 0; i < 16; ++i) S[mt][i] = 0.f;
            {
                constexpr int NKP = DK / 32;
                bf16x8 Kf[2][2 * NMT]; bf16x8 Ql[2][2];
#pragma unroll
                for (int e = 0; e < 2; ++e) {
#pragma unroll
                    for (int mt = 0; mt < NMT; ++mt) Kf[0][e * NMT + mt] = *(const bf16x8*)(Ks + (32 * mt + l31) * QS + 16 * e + 8 * hh);
                    if (!QREG) Ql[0][e] = *(const bf16x8*)(Qs + (32 * wq + l31) * QS + 16 * e + 8 * hh); }
#pragma unroll
                for (int kp = 0; kp < NKP; ++kp) {
                    if (kp + 1 < NKP) {
#pragma unroll
                        for (int e = 0; e < 2; ++e) {
#pragma unroll
                            for (int mt = 0; mt < NMT; ++mt) Kf[(kp + 1) & 1][e * NMT + mt] = *(const bf16x8*)(Ks + (32 * mt + l31) * QS + 16 * (2 * kp + 2 + e) + 8 * hh);
                            if (!QREG) Ql[(kp + 1) & 1][e] = *(const bf16x8*)(Qs + (32 * wq + l31) * QS + 16 * (2 * kp + 2 + e) + 8 * hh); } }
                    __builtin_amdgcn_sched_barrier(0);
#pragma unroll
                    for (int e = 0; e < 2; ++e)
#pragma unroll
                        for (int mt = 0; mt < NMT; ++mt) S[mt] = __builtin_amdgcn_mfma_f32_32x32x16_bf16(Kf[kp & 1][e * NMT + mt], !QREG ? Ql[kp & 1][e] : Qf[QREG ? 2 * kp + e : 0], S[mt], 0, 0, 0);
                    __builtin_amdgcn_sched_barrier(0);
                }
            }
            float mloc = -INFINITY;
#pragma unroll
            for (int mt = 0; mt < NMT; ++mt)
#pragma unroll
                for (int i = 0; i < 16; ++i) { float s = S[mt][i] * scale;
                    if (SAMPLE) { const int key = kt * KT + 32 * mt + (i & 3) + 8 * (i >> 2) + 4 * hh; if (key >= 2064) s = -INFINITY; }
                    S[mt][i] = s; mloc = fmaxf(mloc, s); }
            mloc = fmaxf(mloc, __shfl_xor(mloc, 32));
            const float mnew = fmaxf(m_run, mloc); const float alpha = __builtin_amdgcn_exp2f(m_run - mnew); float psum = 0.f;
#pragma unroll
            for (int mt = 0; mt < NMT; ++mt)
#pragma unroll
                for (int i = 0; i < 16; ++i) { const float p = __builtin_amdgcn_exp2f(S[mt][i] - mnew); S[mt][i] = p; psum += p; }
            l_run = l_run * alpha + psum; m_run = mnew;
#pragma unroll
            for (int d = 0; d < NDT; ++d) Oacc[d] = Oacc[d] * alpha;
            {
                constexpr int NDB = NDT / 4;
                constexpr int NG = 2 * NMT * NDB;
                u32x4 Vf[2][4];
#define ATT_LDV(buf, gi) do { const int _kg = (gi) / NDB, _db = (gi) % NDB; _Pragma("unroll") for (int d = 0; d < 4; ++d) { const bf16_t* vp = Vs + (32 * (4 * _db + d) + l31) * VS + 16 * _kg + 4 * hh; \
                        const u32x2 lo = *(const u32x2*)vp, hi = *(const u32x2*)(vp + 8); Vf[buf][d].x = lo.x; Vf[buf][d].y = lo.y; Vf[buf][d].z = hi.x; Vf[buf][d].w = hi.y; } } while (0)
                ATT_LDV(0, 0);
#pragma unroll
                for (int gi = 0; gi < NG; ++gi) { const int kg = gi / NDB, db = gi % NDB, mt = kg >> 1, s2 = kg & 1;
                    if (gi + 1 < NG) ATT_LDV((gi + 1) & 1, gi + 1);
                    u32x4 pw; pw.x = pk2(S[mt][8 * s2 + 0], S[mt][8 * s2 + 1]); pw.y = pk2(S[mt][8 * s2 + 2], S[mt][8 * s2 + 3]);
                    pw.z = pk2(S[mt][8 * s2 + 4], S[mt][8 * s2 + 5]); pw.w = pk2(S[mt][8 * s2 + 6], S[mt][8 * s2 + 7]);
                    const bf16x8 pf = __builtin_bit_cast(bf16x8, pw);
                    __builtin_amdgcn_sched_barrier(0);
#pragma unroll
                    for (int d = 0; d < 4; ++d) Oacc[4 * db + d] = __builtin_amdgcn_mfma_f32_32x32x16_bf16(__builtin_bit_cast(bf16x8, Vf[gi & 1][d]), pf, Oacc[4 * db + d], 0, 0, 0);
                    __builtin_amdgcn_sched_barrier(0);
                }
#undef ATT_LDV
            }
        }
    }
#undef ATT_ISSUE
    const float l_tot = l_run + __shfl_xor(l_run, 32);
    lds_barrier();
    if (g == 1 && wave_on) { float* e = Ex + (size_t)wq * (NDT * 16 + 2) * 64;
#pragma unroll
        for (int d = 0; d < NDT; ++d)
#pragma unroll
            for (int i = 0; i < 16; ++i) e[(d * 16 + i) * 64 + lane] = Oacc[d][i];
        e[(NDT * 16) * 64 + lane] = m_run; e[(NDT * 16 + 1) * 64 + lane] = l_tot; }
    lds_barrier();
    if (g == 0 && wave_on) { const float* e = Ex + (size_t)wq * (NDT * 16 + 2) * 64;
        const float m1 = e[(NDT * 16) * 64 + lane], l1 = e[(NDT * 16 + 1) * 64 + lane];
        const float m = fmaxf(m_run, m1); const float a0 = exp2f(m_run - m), a1 = exp2f(m1 - m); const float inv = 1.f / (l_tot * a0 + l1 * a1);
        const int qi = 32 * wq + l31;
        bf16_t* op = SAMPLE ? (bf16_t*)(ws + WS_OLAT) + (size_t)(b * 16 + (qi & 15)) * 1024 + (qi >> 4) * 256 : (bf16_t*)(ws + WS_YC) + (size_t)(qb * 128 + qi) * 512 + h * 128;
#pragma unroll
        for (int d = 0; d < NDT; ++d)
#pragma unroll
            for (int i4 = 0; i4 < 4; ++i4) { float o[4];
#pragma unroll
                for (int k = 0; k < 4; ++k) o[k] = (Oacc[d][4 * i4 + k] * a0 + e[(d * 16 + 4 * i4 + k) * 64 + lane] * a1) * inv;
                u32x2 wv; wv.x = pk2(o[0], o[1]); wv.y = pk2(o[2], o[3]); *(u32x2*)(op + 32 * d + 8 * i4 + 4 * hh) = wv; }
    }
    lds_barrier();
}

DI void ffn_act(CP c, int l, int bid, int nb) {
    unsigned char* ws = c->ws; const bf16_t* UP = (const bf16_t*)(ws + WS_UP); bf16_t* ACT = (bf16_t*)(ws + WS_ACT);
    const float* cw = c->in[I_FCW] + (size_t)l * 3 * DFF; const float* cb = c->in[I_FCB] + (size_t)l * DFF;
    const int g = bid * 512 + get_tid(); const int ngroups = (nb * 512) / 352; const int rg = g / 352, cc = (g % 352) * 8;
    if (rg >= ngroups) return;
    const int rows_per = (MT + ngroups - 1) / ngroups; const int r0 = rg * rows_per; const int r1 = (r0 + rows_per < MT) ? r0 + rows_per : MT;
    float w0[8], w1[8], w2[8], bb[8], a0[8], a1[8];
#pragma unroll
    for (int j = 0; j < 8; ++j) { w0[j] = cw[cc + j]; w1[j] = cw[DFF + cc + j]; w2[j] = cw[2 * DFF + cc + j]; bb[j] = cb[cc + j]; a0[j] = 0.f; a1[j] = 0.f; }
    for (int r = r0; r < r1; ++r) {
        const bool samp = r >= MP; const int b = (r - MP) >> 4, t = samp ? (r - MP) & 15 : r;
        float a2[8], vv[8], o[8];
        unpack8(*(const u32x4*)(UP + (size_t)r * 5632 + cc), a2); unpack8(*(const u32x4*)(UP + (size_t)r * 5632 + DFF + cc), vv);
        if (r == r0 || (samp && t == 0)) {
            if (t >= 1) unpack8(*(const u32x4*)(UP + (size_t)(r - 1) * 5632 + cc), a1);
            else {
#pragma unroll
                for (int j = 0; j < 8; ++j) a1[j] = samp ? c->in[I_SFFN][((size_t)(l * 32 + b) * 2 + 1) * DFF + cc + j] : 0.f; }
            if (t >= 2) unpack8(*(const u32x4*)(UP + (size_t)(r - 2) * 5632 + cc), a0);
            else {
#pragma unroll
                for (int j = 0; j < 8; ++j) a0[j] = samp ? c->in[I_SFFN][((size_t)(l * 32 + b) * 2 + t) * DFF + cc + j] : 0.f; }
        }
#pragma unroll
        for (int j = 0; j < 8; ++j) { const float y = w0[j] * a0[j] + w1[j] * a1[j] + w2[j] * a2[j] + bb[j]; o[j] = silu(y) * vv[j]; a0[j] = a1[j]; a1[j] = a2[j]; }
        *(u32x4*)(ACT + (size_t)r * DFF + cc) = pack8(o);
        float* so = nullptr;
        if (!samp && r >= MP - 2) so = c->out + O_PFFN + ((size_t)l * 2 + (r - (MP - 2))) * DFF + cc;
        if (samp && t >= 14) so = c->out + O_SFFN + ((size_t)(l * 32 + b) * 2 + (t - 14)) * DFF + cc;
        if (so) {
#pragma unroll
            for (int j = 0; j < 8; ++j) so[j] = a2[j]; }
    }
}

#define XB_TMO      128
#define XB_XCNT(j)  (256  + 64 * (j))
#define XB_XSUB(j)  (1280 + 64 * (j))
#define XB_XGEN(j)  (2304 + 64 * (j))
#define XB_TOP      3328
#define XB_TOPGEN   3392
#define XB_SPIN_CAP (1u << 20)
DI unsigned xb_ld(unsigned* p) { return __hip_atomic_load(p, __ATOMIC_RELAXED, __HIP_MEMORY_SCOPE_AGENT); }
DI unsigned xb_add(unsigned* p, unsigned v) { return __hip_atomic_fetch_add(p, v, __ATOMIC_RELAXED, __HIP_MEMORY_SCOPE_AGENT); }
DI unsigned xb_xcc_id() { return (unsigned)__builtin_amdgcn_s_getreg((3 << 11) | 20) & 0xFu; }
#define XB_SPIN(cond, bar) do { unsigned _sp = 0; while (cond) { __builtin_amdgcn_s_sleep(1); \
    if ((++_sp & 255u) == 0u) { if (xb_ld(&(bar)[XB_TMO])) break; if (_sp > XB_SPIN_CAP) { atomicAdd(&(bar)[XB_TMO], 1u); break; } } } } while (0)
DI void xcd_barrier(unsigned* bar, unsigned x, volatile LAS unsigned* st, unsigned G) {
    asm volatile("s_waitcnt vmcnt(0)" ::: "memory");
    __syncthreads();
    if (get_tid() == 0) {
        __builtin_amdgcn_s_waitcnt(0);
        unsigned nloc = st[0], nx = st[1];
        if (nloc == 0u) {
            unsigned sum, cnt, mine, sp = 0u;
            for (;;) { sum = 0u; cnt = 0u; mine = 0u;
#pragma unroll
                for (unsigned j = 0; j < 16; ++j) { const unsigned cj = xb_ld(&bar[XB_XCNT(j)]); sum += cj; cnt += (cj > 0u) ? 1u : 0u; mine = (j == x) ? cj : mine; }
                if (sum == G) break;
                __builtin_amdgcn_s_sleep(1);
                if ((++sp & 255u) == 0u) { if (xb_ld(&bar[XB_TMO])) break; if (sp > XB_SPIN_CAP) { atomicAdd(&bar[XB_TMO], 1u); break; } } }
            nloc = mine > 0u ? mine : 1u; nx = cnt > 0u ? cnt : 1u; st[0] = nloc; st[1] = nx; }
        const unsigned old = xb_add(&bar[XB_XSUB(x)], 1u);
        const unsigned gen = old / nloc;
        if (old + 1u == (gen + 1u) * nloc) {
            __builtin_amdgcn_fence(__ATOMIC_RELEASE, "agent");
            asm volatile("s_waitcnt vmcnt(0)" ::: "memory");
            const unsigned og = xb_add(&bar[XB_TOP], 1u);
            const unsigned tg = og / nx;
            if (og + 1u == (tg + 1u) * nx) xb_add(&bar[XB_TOPGEN], 1u);
            else XB_SPIN(xb_ld(&bar[XB_TOPGEN]) == tg, bar);
            __builtin_amdgcn_fence(__ATOMIC_ACQUIRE, "agent");
            xb_add(&bar[XB_XGEN(x)], 1u);
            asm volatile("s_waitcnt vmcnt(0)" ::: "memory");
        } else {
            XB_SPIN(xb_ld(&bar[XB_XGEN(x)]) == gen, bar);
            __builtin_amdgcn_fence(__ATOMIC_ACQUIRE, "agent");
            asm volatile("s_waitcnt vmcnt(0)" ::: "memory");
        }
    }
    __syncthreads();
}

DI void grid_barrier(unsigned* ctr, unsigned target) {
    __syncthreads();
    if (get_tid() == 0) {
        __builtin_amdgcn_fence(__ATOMIC_RELEASE, "agent");
        asm volatile("s_waitcnt vmcnt(0) lgkmcnt(0)" ::: "memory");
        __hip_atomic_fetch_add(ctr, 1u, __ATOMIC_RELAXED, __HIP_MEMORY_SCOPE_AGENT);
        while (__hip_atomic_load(ctr, __ATOMIC_RELAXED, __HIP_MEMORY_SCOPE_AGENT) < target) __builtin_amdgcn_s_sleep(2);
        __builtin_amdgcn_fence(__ATOMIC_ACQUIRE, "agent");
        asm volatile("s_waitcnt vmcnt(0) lgkmcnt(0)" ::: "memory");
    }
    __syncthreads();
}

DI void latt_build(CP c, int L, float* tile, int bid, int nb) {
    unsigned char* ws = c->ws; const int tid = get_tid();
    for (int b = 0; b < 32; ++b) transpose_cvt(c->in[I_CLAT] + ((size_t)(L * 32 + b) * 2048) * 256, 2048, 256, 256, (bf16_t*)(ws + WS_LATT) + (size_t)b * 256 * LTS, LTS, tile, (bid + 8 * b) % nb, nb);
    for (int i = bid * 512 + tid; i < 32 * 256 * 6; i += nb * 512) { const int row = i / 6, sg = i % 6; *(u32x4*)((bf16_t*)(ws + WS_LATT) + (size_t)row * LTS + 2064 + sg * 8) = (u32x4){0u, 0u, 0u, 0u}; }
}

DI int gemm_job_count(int ph) {
    if (ph == 1) return 1;
    if (ph < 3) return 0;
    const int sub = (ph - 3) % NSUB;
    if (sub == 0) return 1; if (sub == 2) return 4; if (sub == 5) return 6; if (sub == 6) return 1; if (sub == 8) return 1; if (sub == 10) return 1;
    return 0;
}
DI GemmJob make_job(CP c, int ph, int j) {
    unsigned char* ws = c->ws; GemmJob J; J.split = 1 << 30; J.o2 = nullptr; J.ld2 = 0; J.f1 = nullptr; J.row0 = 0; J.flag = 0; J.cstart = 0;
    const float* MOD = (const float*)(ws + WS_MOD);
    if (ph == 1) { J.A = (const bf16_t*)(ws + WS_SC); J.Bt = (const bf16_t*)(ws + WS_WADA); J.M = 256; J.N = 12288; J.K = 1024; J.lda = 1024; J.ldb = 1024; J.mode = 0;
        J.o1 = (void*)(ws + WS_MOD); J.ld1 = 12288; J.f1 = c->in[I_BADA]; J.flag = 64; return J; }
    const int l = (ph - 3) / NSUB, sub = (ph - 3) % NSUB;
    if (sub == 0) { J.A = (const bf16_t*)(ws + WS_H); J.Bt = (const bf16_t*)(ws + WS_WIN); J.M = MT; J.N = NIN; J.K = 1024; J.lda = 1024; J.ldb = 1024; J.mode = 1;
        J.o1 = ws + WS_Z1; J.ld1 = NZ1; J.o2 = ws + WS_G; J.ld2 = NG; J.split = NZ1; }
    else if (sub == 2) {
        J.mode = 1;
        if (j == 0) { J.A = (const bf16_t*)(ws + WS_QN); J.Bt = (const bf16_t*)(ws + WS_WUQ); J.M = MT; J.N = 768; J.K = 384; J.lda = 384; J.ldb = 384; J.o1 = ws + WS_Q; J.ld1 = 768; }
        else if (j == 1) { J.A = (const bf16_t*)(ws + WS_LAT); J.Bt = (const bf16_t*)(ws + WS_WUK); J.M = MP; J.N = 512; J.K = 256; J.lda = 256; J.ldb = 256; J.o1 = ws + WS_KN; J.ld1 = 512; }
        else if (j == 2) { J.A = (const bf16_t*)(ws + WS_WUV); J.Bt = (const bf16_t*)(ws + WS_LAT); J.M = 512; J.N = MP; J.K = 256; J.lda = 256; J.ldb = 256; J.o1 = ws + WS_VT; J.ld1 = MP; }
        else { J.A = (const bf16_t*)(ws + WS_QN) + (size_t)MP * 384; J.Bt = (const bf16_t*)(ws + WS_WQABS); J.M = MS; J.N = 1024; J.K = 384; J.lda = 384; J.ldb = 384; J.o1 = ws + WS_QABS; J.ld1 = 1024; }
        J.cstart = (j == 0) ? 0 : (j == 1 ? 206 : (j == 2 ? 78 : 198));
    } else if (sub == 5) {
        const int i = j >> 1, sp = j & 1; const size_t r0 = sp ? MP : 0; J.mode = 2; J.M = sp ? MS : MP; J.N = 1024; J.flag = (i == 0);
        J.o1 = (bf16_t*)(ws + WS_MG) + r0 * 1024; J.ld1 = 1024; J.o2 = (bf16_t*)(ws + WS_G) + r0 * NG + i * 1024; J.ld2 = NG;
        if (i == 2 && sp) { J.A = (const bf16_t*)(ws + WS_OLAT); J.Bt = (const bf16_t*)(ws + WS_WBRC); J.K = 1024; J.lda = 1024; J.ldb = 1024; }
        else { J.A = (const bf16_t*)(ws + (i == 0 ? WS_YA : (i == 1 ? WS_YB : WS_YC))) + r0 * 512; J.Bt = (const bf16_t*)(ws + WS_WBR) + (size_t)i * 1024 * 512; J.K = 512; J.lda = 512; J.ldb = 512; }
    } else if (sub == 6) { J.A = (const bf16_t*)(ws + WS_MG); J.Bt = (const bf16_t*)(ws + WS_WOUT); J.M = MT; J.N = 1024; J.K = 1024; J.lda = 1024; J.ldb = 1024; J.mode = 3;
        J.o1 = ws + WS_XB; J.ld1 = 1024; J.f1 = MOD + l * 6144 + 2 * 1024; }
    else if (sub == 8) { J.A = (const bf16_t*)(ws + WS_H); J.Bt = (const bf16_t*)(ws + WS_WUP); J.M = MT; J.N = 5632; J.K = 1024; J.lda = 1024; J.ldb = 1024; J.mode = 1; J.o1 = ws + WS_UP; J.ld1 = 5632; }
    else { J.A = (const bf16_t*)(ws + WS_ACT); J.Bt = (const bf16_t*)(ws + WS_WDN); J.M = MT; J.N = 1024; J.K = DFF; J.lda = DFF; J.ldb = DFF; J.mode = 3;
        J.o1 = ws + WS_XB; J.ld1 = 1024; J.f1 = MOD + l * 6144 + 5 * 1024; }
    return J;
}

__global__ void __launch_bounds__(512) fwd_megakernel(Ctx carg) {
    extern __shared__ __attribute__((aligned(16))) unsigned char smem[];
    cg::grid_group grid = cg::this_grid();
    const int bid = blockIdx.x, nb = gridDim.x;
    CP c0 = (CP)__builtin_amdgcn_kernarg_segment_ptr();
    int nbar = 0;
    volatile LAS unsigned* xst = (volatile LAS unsigned*)((LAS unsigned char*)smem + LDS_MISC + 64);
    const unsigned xcc = xb_xcc_id();
    if (threadIdx.x == 0) { xst[0] = 0u; xst[1] = 0u; (void)xb_add((unsigned*)(carg.ws + WS_CTL) + XB_XCNT(xcc), 1u); }
    __syncthreads();
    for (int ph = carg.ph_lo; ph < carg.ph_hi; ++ph) {
      const int nrep = (PROBE_DUP >= 0 && ((PROBE_DUP == 100 && ph == 0) || (ph >= 3 && (ph - 3) % NSUB == PROBE_DUP))) ? 2 : 1;
      for (int rep = 0; rep < nrep; ++rep) {
        CP c = c0; asm volatile("" : "+s"(c));
        const int tid = get_tid(), lane = tid & 63, wave = tid >> 6;
        unsigned char* ws = c->ws; const float* MOD = (const float*)(ws + WS_MOD);
        const int njobs = gemm_job_count(ph);
        for (int j = 0; j < njobs; ++j) { const GemmJob J = make_job(c, ph, j); gemm_phase((LAS unsigned char*)smem, J, nb, (nb == 256) ? ((bid + 256 - J.cstart) & 255) : bid); }
        if (ph == 0) { convert_weights(c, 0, (float*)smem, bid, nb, 7); prep_once(c, (float*)smem, bid, nb); }
        else if (ph == 1) { const int skip = (nb > 96) ? 48 : 0;
            if (bid >= skip) ln_pass(c, 0, c->in[I_LN0G], c->in[I_LN0B], nullptr, nullptr, bid - skip, nb - skip, false); }
        else if (ph == 2) { ln_pass(c, 1, nullptr, nullptr, MOD + 1024, MOD, bid, nb, false); }
        else {
            const int l = (ph - 3) / NSUB, sub = (ph - 3) % NSUB;
            if (l == 0 && bid >= 8 && sub == 5) { convert_weights(c, 1, (float*)smem, bid - 8, nb - 8, 1); latt_build(c, 1, (float*)smem, bid - 8, nb - 8); }
            if (l == 0 && bid >= 8 && sub == 10) convert_weights(c, 1, (float*)smem, bid - 8, nb - 8, 2);
            if (sub == 1) {
                for (int it = bid; it < NITEM_GDN; it += nb) gdn_chunk(c, l, it, (float*)smem);
                for (int it = (nb == 256) ? ((bid + 128) & 255) : bid; it < 544; it += nb) conva_tile(c, l, it, (float*)smem);
                if (l == 0 || nb <= 8) latt_build(c, l, (float*)smem, bid, nb);
                for (int r = bid * 8 + wave; r < MT; r += nb * 8) mla_row(c, l, r, lane);
            } else if (sub == 3) {
                unsigned* qctr = (unsigned*)(ws + WS_CTL) + 16 + l + 2 * rep; volatile int* sitem = (volatile int*)(smem + LDS_MISC);
                if (bid < 12) gdn_scan(c, l, 0, bid & 3, 1 + (bid >> 2), smem);
                for (;;) {
                    lds_barrier();
                    if (tid == 0) *sitem = (int)atomicAdd(qctr, 1u);
                    lds_barrier();
                    const int it = *sitem;
                    if (it >= 128 + 32 + 512) break;
                    if (it < 128) gdn_scan(c, l, 1 + (it >> 2), it & 3, 0, smem);
                    else if (it < 160) attn_item<320, 256, 32, true>(c, l, it - 128, 0, smem);
                    else { const int k = it - 160; attn_item<192, 128, 64, false>(c, l, 127 - (k >> 2), k & 3, smem); }
                }
            } else if (sub == 4) { for (int it = bid; it < NITEM_GDN + 4; it += nb) gdn_out(c, l, it, smem); }
            else if (sub == 7) { ln_pass(c, 2, c->in[I_LN1G] + l * 1024, c->in[I_LN1B] + l * 1024, MOD + l * 6144 + 4 * 1024, MOD + l * 6144 + 3 * 1024, bid, nb, false); }
            else if (sub == 9) { ffn_act(c, l, bid, nb); }
            else if (sub == 11) {
                if (l == 0) { ln_pass(c, 2, c->in[I_LN2G], c->in[I_LN2B], MOD + 6144 + 1024, MOD + 6144, bid, nb, false); convert_weights(c, 1, (float*)smem, bid, nb, 4); }
                else ln_pass(c, 2, c->in[I_LN2G] + 1024, c->in[I_LN2B] + 1024, nullptr, nullptr, bid, nb, true);
            }
        }
        if (ph + 1 < carg.ph_hi || rep + 1 < nrep) {
            if (carg.ph_lo < 0) grid.sync();
            xcd_barrier((unsigned*)(ws + WS_CTL), xcc, xst, (unsigned)nb);
            ++nbar;
        }
      }
    }
}

extern "C" void kernel_launch(void* const* d_in, const int* in_sizes, int n_in, void* d_out, int out_size, void* d_ws, size_t ws_size, hipStream_t stream) {
    static int grid_blocks = 0;
    if (grid_blocks == 0) {
        if (n_in != N_IN || (size_t)out_size != O_END || ws_size < WS_END) { fprintf(stderr, "kernel_launch: unexpected shapes n_in %d out %d ws %zu (need %zu)\n", n_in, out_size, ws_size, (size_t)WS_END); grid_blocks = -1; return; }
        int dev = 0, cus = 0, per_cu = 0;
        hipGetDevice(&dev); hipDeviceGetAttribute(&cus, hipDeviceAttributeMultiprocessorCount, dev);
        if (hipFuncSetAttribute((const void*)fwd_megakernel, hipFuncAttributeMaxDynamicSharedMemorySize, LDS_BYTES) != hipSuccess) { fprintf(stderr, "kernel_launch: hipFuncSetAttribute failed\n"); grid_blocks = -1; return; }
        hipOccupancyMaxActiveBlocksPerMultiprocessor(&per_cu, (const void*)fwd_megakernel, 512, LDS_BYTES);
        (void)hipGetLastError();
        if (per_cu < 1) per_cu = 1;
        grid_blocks = cus;
    }
    if (grid_blocks < 0) return;
    hipMemsetAsync((char*)d_ws + WS_CTL, 0, WS_CTL_BYTES, stream);
    Ctx c{};
    for (int i = 0; i < N_IN; ++i) c.in[i] = (const float*)d_in[i];
    c.out = (float*)d_out; c.ws = (unsigned char*)d_ws; c.ph_lo = 0; c.ph_hi = NPHASE;
    void* args[] = {&c};
    hipError_t e = hipLaunchCooperativeKernel((const void*)fwd_megakernel, dim3(grid_blocks), dim3(512), args, LDS_BYTES, stream);
    if (e != hipSuccess) fprintf(stderr, "cooperative launch failed: %s (grid %d)\n", hipGetErrorString(e), grid_blocks);
}
```

```cpp
#include <hip/hip_runtime.h>
#include <hip/hip_cooperative_groups.h>
#include <cstdio>
namespace cg = cooperative_groups;

#define DI __device__ __forceinline__
#define LAS __attribute__((address_space(3)))
typedef unsigned short bf16_t;
typedef short bf16x8 __attribute__((ext_vector_type(8)));
typedef short s16x4 __attribute__((ext_vector_type(4)));
typedef float f32x4 __attribute__((ext_vector_type(4)));
typedef float f32x16 __attribute__((ext_vector_type(16)));
typedef unsigned u32x4 __attribute__((ext_vector_type(4)));
typedef unsigned u32x2 __attribute__((ext_vector_type(2)));

constexpr int MP = 16384, MS = 512, MT = MP + MS, DM = 1024, NZ1 = 3840, NG = 3072, NIN = NZ1 + NG, DFF = 2816;
constexpr int NITEM_GDN = 1152;
enum { I_XP = 0, I_XS, I_CLAT, I_CKPE, I_SCA, I_SGC, I_SGDN, I_SFFN, I_CP, I_CS, I_LN0G, I_LN0B, I_WADA, I_BADA, I_WIN, I_CAW, I_CAB,
       I_LNAG, I_LNAB, I_GCW, I_ALOG, I_DTB, I_GNG, I_QNG, I_KVNG, I_WUQ, I_WUKV, I_WBR, I_WOUT, I_LN1G, I_LN1B, I_WUP, I_FCW, I_FCB,
       I_WDN, I_LN2G, I_LN2B, N_IN };
constexpr size_t O_YP = 0, O_YS = O_YP + (size_t)MP * DM, O_PLAT = O_YS + (size_t)MS * DM, O_PKPE = O_PLAT + 2ull * MP * 256,
                 O_PCA = O_PKPE + 2ull * MP * 64, O_PGC = O_PCA + 2ull * 30 * 512, O_PGDN = O_PGC + 2ull * 3 * 1536,
                 O_PFFN = O_PGDN + 2ull * 4 * 16384, O_SLAT = O_PFFN + 2ull * 2 * DFF, O_SKPE = O_SLAT + 2ull * 32 * 16 * 256,
                 O_SCA = O_SKPE + 2ull * 32 * 16 * 64, O_SGC = O_SCA + 2ull * 32 * 30 * 512, O_SGDN = O_SGC + 2ull * 32 * 3 * 1536,
                 O_SFFN = O_SGDN + 2ull * 32 * 4 * 16384, O_END = O_SFFN + 2ull * 32 * 2 * DFF;
constexpr size_t al256(size_t x) { return (x + 255) & ~(size_t)255; }
constexpr size_t WS_CTL = 0, WS_CTL_BYTES = 16384, WS_MOD = WS_CTL_BYTES, WS_SC = WS_MOD + 64ull * 12288 * 4, WS_ROPE = WS_SC + 256ull * 1024 * 2,
                 WS_WIN = WS_ROPE + 16384ull * 32 * 8, WS_WUQ = WS_WIN + (size_t)NIN * 1024 * 2, WS_WUK = WS_WUQ + 768ull * 384 * 2,
                 WS_WUV = WS_WUK + 512ull * 256 * 2, WS_WQABS = WS_WUV + 512ull * 256 * 2, WS_WBR = WS_WQABS + 1024ull * 384 * 2,
                 WS_WBRC = WS_WBR + 3ull * 1024 * 512 * 2, WS_WOUT = WS_WBRC + 1024ull * 1024 * 2, WS_WUP = WS_WOUT + 1024ull * 1024 * 2,
                 WS_WDN = WS_WUP + 5632ull * 1024 * 2, WS_AB = WS_WDN + 1024ull * 2816 * 2;
constexpr size_t WS_Z1 = WS_AB, WS_G = WS_Z1 + (size_t)MT * NZ1 * 2, WS_UP = WS_AB, WS_WADA = WS_AB;
constexpr size_t WS_Q = WS_AB, WS_KN = WS_Q + (size_t)MT * 768 * 2, WS_VT = WS_KN + (size_t)MP * 512 * 2, WS_QABS = WS_VT + 512ull * MP * 2,
                 WS_YB = WS_QABS + 512ull * 1024 * 2, WS_YC = WS_YB + (size_t)MT * 512 * 2, WS_OLAT = WS_YC + (size_t)MT * 512 * 2,
                 WS_ABUSED = WS_OLAT + 512ull * 1024 * 2;
static_assert(WS_ABUSED <= WS_G, "region A overflow");
constexpr size_t WS_C = WS_G + (size_t)MT * NG * 2;
constexpr size_t WS_QN = WS_C, WS_LAT = WS_QN + (size_t)MT * 384 * 2, WS_KPE = WS_LAT + (size_t)MT * 256 * 2, WS_YA = WS_KPE + (size_t)MT * 64 * 2,
                 WS_SZ = WS_YA + (size_t)MT * 512 * 2, WS_U = WS_SZ + (size_t)MT * 512 * 2, WS_W = WS_U + (size_t)NITEM_GDN * 64 * 128 * 2,
                 WS_QD = WS_W + (size_t)NITEM_GDN * 64 * 128 * 2, WS_KDT = WS_QD + (size_t)NITEM_GDN * 64 * 128 * 2,
                 WS_QK = WS_KDT + (size_t)NITEM_GDN * 64 * 128 * 2, WS_EGL = WS_QK + (size_t)NITEM_GDN * 64 * 64 * 2, WS_CEND = WS_EGL + 8192;
constexpr size_t WS_H = WS_YA, WS_ACT = WS_C, WS_MG = WS_U;
constexpr size_t WS_SNP = WS_ABUSED, WS_SNS = WS_QN;
static_assert(WS_SNP + 1024ull * 32768 <= WS_G, "Sn prompt overflow");
static_assert(128ull * 32768 <= (size_t)MT * 384 * 2, "Sn sample overflow");
static_assert((size_t)MT * DFF * 2 <= WS_CEND - WS_C, "ACT overflow");
static_assert((size_t)MT * 5632 * 2 <= WS_C - WS_AB, "UP overflow");
constexpr int LTS = 2112;
constexpr size_t WS_LATT = WS_CEND, WS_XTRA = WS_LATT + 32ull * 256 * LTS * 2, WS_END = WS_XTRA + 72ull * 1024 * 1024;
constexpr size_t WS_XA = WS_XTRA, WS_XA256 = WS_XA + 512ull * 32768, WS_XS128 = WS_XA256 + 4ull * 32768;
constexpr size_t WS_XB = WS_XS128 + 4ull * 32768;
static_assert(WS_XB + (size_t)MT * 1024 * 2 <= WS_END, "XB overflow");
constexpr int LDS_BYTES = 160 * 1024;
constexpr int LDS_MISC = LDS_BYTES - 256;
constexpr int NSUB = 12;
constexpr int NPHASE = 3 + NSUB * 2;
constexpr float DN_ALPHA = 1.4142135623730951f;

#ifndef PROBE_DUP
#define PROBE_DUP (-1)
#endif
struct Ctx { const float* in[N_IN]; float* out; unsigned char* ws; int ph_lo, ph_hi; };
typedef const __attribute__((address_space(4))) Ctx* CP;

DI float bf2f(bf16_t b) { return __uint_as_float(((unsigned)b) << 16); }
DI bf16_t f2bf(float f) { unsigned u = __float_as_uint(f); u += 0x7FFFu + ((u >> 16) & 1u); return (bf16_t)(u >> 16); }
typedef __bf16 hwbf2_t __attribute__((ext_vector_type(2)));
typedef float hwf2_t __attribute__((ext_vector_type(2)));
DI unsigned pk2(float lo, float hi) { const hwf2_t v = {lo, hi}; const hwbf2_t b = __builtin_convertvector(v, hwbf2_t); return __builtin_bit_cast(unsigned, b); }
DI float lo16(unsigned w) { return __uint_as_float(w << 16); }
DI float hi16(unsigned w) { return __uint_as_float(w & 0xffff0000u); }
DI void unpack8(u32x4 w, float* v) { v[0] = lo16(w.x); v[1] = hi16(w.x); v[2] = lo16(w.y); v[3] = hi16(w.y); v[4] = lo16(w.z); v[5] = hi16(w.z); v[6] = lo16(w.w); v[7] = hi16(w.w); }
DI u32x4 pack8(const float* v) { u32x4 w; w.x = pk2(v[0], v[1]); w.y = pk2(v[2], v[3]); w.z = pk2(v[4], v[5]); w.w = pk2(v[6], v[7]); return w; }
DI float wave_sum(float v) { for (int o = 32; o >= 1; o >>= 1) v += __shfl_xor(v, o); return v; }
DI float fexp(float x) { return __builtin_amdgcn_exp2f(x * 1.4426950408889634f); }
DI float sigm(float x) { return __builtin_amdgcn_rcpf(1.f + fexp(-x)); }
DI float silu(float x) { return x * __builtin_amdgcn_rcpf(1.f + fexp(-x)); }
DI int get_tid() { int t = (int)threadIdx.x; asm volatile("" : "+v"(t)); return t; }
DI void lds_barrier() { asm volatile("s_waitcnt lgkmcnt(0)" ::: "memory"); __builtin_amdgcn_s_barrier(); asm volatile("" ::: "memory"); }
DI int modrow_of(int r) { return r < MP ? 0 : 1 + ((r - MP) >> 4); }

namespace pg8 {
constexpr int BM = 256, BK = 64, HALF = 128, HTB = HALF * BK * 2, NXCD = 8, WGM = 4;
__host__ __device__ __forceinline__ int lds_byte(int r, int c) { const int st = (r >> 4) * 2 + (c >> 5), rr = r & 15, cc = c & 31, ob = rr * 64 + cc * 2; return st * 1024 + (ob ^ (((ob >> 9) & 1) << 5)); }
__host__ __device__ __forceinline__ void stage_rc(int b, int& R, int& C) { const int st = b / 1024, sb = b % 1024, swz = sb ^ (((sb >> 9) & 1) << 5); R = (st >> 1) * 16 + swz / 64; C = (st & 1) * 32 + (swz % 64) / 2; }
__host__ __device__ __forceinline__ int perm32(int rho) { const int n = rho >> 4, i = rho & 15; return 8 * (i >> 2) + 4 * n + (i & 3); }
struct Unit { int pm, pn; };
struct StaticOrder {
    int nM, nN, nwg, G, c;
    __device__ void init(int M, int N, int G_, int c_) { nM = M / BM; nN = N / BM; nwg = nM * nN; G = G_; c = c_; }
    __device__ bool next(int i, Unit& u) const {
        const long L = (long)i * G + c; if (L >= nwg) return false;
        int wgid = (int)L; { const int q = nwg / NXCD, r = nwg % NXCD, xcd = wgid % NXCD, off = wgid / NXCD; wgid = (xcd < r ? xcd * (q + 1) : r * (q + 1) + (xcd - r) * q) + off; }
        const int nig = WGM * nN, gid = wgid / nig, fm = gid * WGM, gsz = (nM - fm) < WGM ? (nM - fm) : WGM;
        u.pm = fm + ((wgid % nig) % gsz); u.pn = (wgid % nig) / gsz; return true;
    }
};
}

struct GemmJob { const bf16_t* A; const bf16_t* Bt; int M, N, K, lda, ldb, mode; void* o1; int ld1; void* o2; int ld2; int split; const float* f1; int row0; int flag; int cstart; };

DI void gemm_epilogue(const GemmJob& J, const f32x4 (&acc)[2][2][4][2], const pg8::Unit& u, int wr, int wc, int fr, int fq) {
    const int rloc0 = u.pm * 256 + wr * 64 + fr;
    if (J.mode == 0) {
        float* C = (float*)J.o1; const int col0 = u.pn * 256 + wc * 32 + 4 * fq;
#pragma unroll
        for (int ai = 0; ai < 2; ++ai)
#pragma unroll
            for (int m = 0; m < 4; ++m) { const int row = rloc0 + ai * 128 + m * 16;
                if (row < J.flag) {
#pragma unroll
                    for (int bj = 0; bj < 2; ++bj)
#pragma unroll
                        for (int n = 0; n < 2; ++n) { const int col = col0 + bj * 128 + n * 16; const f32x4 b = *(const f32x4*)(J.f1 + col);
                            *(f32x4*)(C + (size_t)row * J.ld1 + col) = acc[ai][bj][m][n] + b; } }
                asm volatile("" ::: "memory"); }
    } else if (J.mode == 1) {
        int colt = u.pn * 256; bf16_t* base = (bf16_t*)J.o1; int ld = J.ld1;
        if (colt >= J.split) { base = (bf16_t*)J.o2; ld = J.ld2; colt -= J.split; }
        const int col0 = colt + wc * 32 + 8 * fq;
#pragma unroll
        for (int ai = 0; ai < 2; ++ai)
#pragma unroll
            for (int m = 0; m < 4; ++m) { bf16_t* rowp = base + (size_t)(rloc0 + ai * 128 + m * 16) * ld + col0;
#pragma unroll
                for (int bj = 0; bj < 2; ++bj) { const f32x4 v0 = acc[ai][bj][m][0], v1 = acc[ai][bj][m][1];
                    u32x4 w; w.x = pk2(v0[0], v0[1]); w.y = pk2(v0[2], v0[3]); w.z = pk2(v1[0], v1[1]); w.w = pk2(v1[2], v1[3]);
                    *(u32x4*)(rowp + bj * 128) = w; }
                asm volatile("" ::: "memory"); }
    } else if (J.mode == 2) {
        bf16_t* MG = (bf16_t*)J.o1; const bf16_t* Gt = (const bf16_t*)J.o2; const int col0 = u.pn * 256 + wc * 32 + 8 * fq;
        u32x4 gb[2][2], pb[2][2];
#pragma unroll
        for (int bj = 0; bj < 2; ++bj) { gb[0][bj] = *(const u32x4*)(Gt + (size_t)rloc0 * J.ld2 + col0 + bj * 128); pb[0][bj] = (u32x4){0u, 0u, 0u, 0u};
            if (!J.flag) pb[0][bj] = *(const u32x4*)(MG + (size_t)rloc0 * J.ld1 + col0 + bj * 128); }
#pragma unroll
        for (int it = 0; it < 8; ++it) { const int ai = it >> 2, m = it & 3; const int row = rloc0 + ai * 128 + m * 16;
            if (it + 1 < 8) { const int rown = rloc0 + ((it + 1) >> 2) * 128 + ((it + 1) & 3) * 16;
#pragma unroll
                for (int bj = 0; bj < 2; ++bj) { gb[(it + 1) & 1][bj] = *(const u32x4*)(Gt + (size_t)rown * J.ld2 + col0 + bj * 128); pb[(it + 1) & 1][bj] = (u32x4){0u, 0u, 0u, 0u};
                    if (!J.flag) pb[(it + 1) & 1][bj] = *(const u32x4*)(MG + (size_t)rown * J.ld1 + col0 + bj * 128); } }
            __builtin_amdgcn_sched_barrier(0);
#pragma unroll
            for (int bj = 0; bj < 2; ++bj) { float g[8], p[8], a[8]; unpack8(gb[it & 1][bj], g); unpack8(pb[it & 1][bj], p);
                const f32x4 v0 = acc[ai][bj][m][0], v1 = acc[ai][bj][m][1];
                a[0] = v0[0]; a[1] = v0[1]; a[2] = v0[2]; a[3] = v0[3]; a[4] = v1[0]; a[5] = v1[1]; a[6] = v1[2]; a[7] = v1[3];
#pragma unroll
                for (int j = 0; j < 8; ++j) a[j] = a[j] * sigm(g[j]) + p[j];
                *(u32x4*)(MG + (size_t)row * J.ld1 + col0 + bj * 128) = pack8(a); }
            __builtin_amdgcn_sched_barrier(0); }
    } else {
        bf16_t* X = (bf16_t*)J.o1;
        u32x2 xb[2][4]; f32x4 gg[2][4];
        { const float* gp = J.f1 + (size_t)modrow_of(J.row0 + rloc0) * 12288;
#pragma unroll
          for (int q = 0; q < 4; ++q) { const int col = u.pn * 256 + (q >> 1) * 128 + wc * 32 + (q & 1) * 16 + 4 * fq; xb[0][q] = *(const u32x2*)(X + (size_t)rloc0 * J.ld1 + col); gg[0][q] = *(const f32x4*)(gp + col); } }
#pragma unroll
        for (int it = 0; it < 8; ++it) { const int ai = it >> 2, m = it & 3; const int row = rloc0 + ai * 128 + m * 16;
            if (it + 1 < 8) { const int rown = rloc0 + ((it + 1) >> 2) * 128 + ((it + 1) & 3) * 16; const float* gp = J.f1 + (size_t)modrow_of(J.row0 + rown) * 12288;
#pragma unroll
                for (int q = 0; q < 4; ++q) { const int col = u.pn * 256 + (q >> 1) * 128 + wc * 32 + (q & 1) * 16 + 4 * fq; xb[(it + 1) & 1][q] = *(const u32x2*)(X + (size_t)rown * J.ld1 + col); gg[(it + 1) & 1][q] = *(const f32x4*)(gp + col); } }
            __builtin_amdgcn_sched_barrier(0);
#pragma unroll
            for (int q = 0; q < 4; ++q) { const int bj = q >> 1, n = q & 1; const int col = u.pn * 256 + bj * 128 + wc * 32 + n * 16 + 4 * fq;
                const u32x2 xw = xb[it & 1][q]; const f32x4 xv = (f32x4){lo16(xw.x), hi16(xw.x), lo16(xw.y), hi16(xw.y)};
                const f32x4 o = xv * DN_ALPHA + (gg[it & 1][q] + 1.0f) * acc[ai][bj][m][n];
                u32x2 w; w.x = pk2(o[0], o[1]); w.y = pk2(o[2], o[3]); *(u32x2*)(X + (size_t)row * J.ld1 + col) = w; }
            __builtin_amdgcn_sched_barrier(0); }
    }
}

DI void gemm_phase(LAS unsigned char* lds, const GemmJob& g, int G, int cidx) {
    using namespace pg8;
    const int tid = get_tid(), wid = __builtin_amdgcn_readfirstlane(tid >> 6), lane = tid & 63, wr = wid >> 2, wc = wid & 3, fr = lane & 15, fq = lane >> 4;
    const int nt = g.K / BK;
    StaticOrder S; S.init(g.M, g.N, G, cidx);
    const bool perm = (g.mode == 1 || g.mode == 2);
    unsigned voffA[2], voffB[2];
#pragma unroll
    for (int i = 0; i < 2; ++i) { int R, C; stage_rc(tid * 16 + i * 8192, R, C); const int Rb = perm ? ((R & ~31) + perm32(R & 31)) : R;
        voffA[i] = (unsigned)(R * g.lda + C) * 2u; voffB[i] = (unsigned)(Rb * g.ldb + C) * 2u; }
    const size_t kstep = (size_t)(BK * 2);
    const size_t hstepA = (size_t)HALF * g.lda * 2, hstepB = (size_t)HALF * g.ldb * 2;
    const size_t tstepA = 2 * hstepA, tstepB = 2 * hstepB;
    const unsigned ldsw = (unsigned)wid * 1024u;
    const int aoff = lds_byte(wr * 64 + fr, fq * 8), boff = lds_byte(wc * 32 + fr, fq * 8);
#define PG8_SA(b, h) (((b) * 2 + (h)) * HTB)
#define PG8_SB(b, h) ((4 + (b) * 2 + (h)) * HTB)
#define PG8_STAGE(bufoff, gbase, voff) do { _Pragma("unroll") for (int _i = 0; _i < 2; ++_i) \
        __builtin_amdgcn_global_load_lds((const unsigned*)((const char*)(gbase) + (voff)[_i]), (LAS unsigned*)(lds + (bufoff) + ldsw + _i * 8192), 16, 0, 0); } while (0)
#define PG8_LDA(dst, b, h) do { _Pragma("unroll") for (int m = 0; m < 4; ++m) _Pragma("unroll") for (int k = 0; k < 2; ++k) dst[m][k] = *(const LAS bf16x8*)(lds + PG8_SA(b, h) + aoff + m * 2048 + k * 1024); } while (0)
#define PG8_LDB(dst, b, h) do { _Pragma("unroll") for (int n = 0; n < 2; ++n) _Pragma("unroll") for (int k = 0; k < 2; ++k) dst[n][k] = *(const LAS bf16x8*)(lds + PG8_SB(b, h) + boff + n * 2048 + k * 1024); } while (0)
#define PG8_MMA(ai, bj, At, Bt) do { __builtin_amdgcn_s_setprio(1); _Pragma("unroll") for (int m = 0; m < 4; ++m) _Pragma("unroll") for (int n = 0; n < 2; ++n) _Pragma("unroll") for (int k = 0; k < 2; ++k) \
        acc[ai][bj][m][n] = __builtin_amdgcn_mfma_f32_16x16x32_bf16(Bt[n][k], At[m][k], acc[ai][bj][m][n], 0, 0, 0); __builtin_amdgcn_s_setprio(0); } while (0)
#define PG8_WAIT_V(n) asm volatile("s_waitcnt vmcnt(" #n ")" ::: "memory")
#define PG8_WAIT_L(n) asm volatile("s_waitcnt lgkmcnt(" #n ")" ::: "memory")
#define PG8_BAR __builtin_amdgcn_s_barrier()
#define PG8_SCHED __builtin_amdgcn_sched_barrier(0)
    Unit cur, nxt; int ui = 0;
    if (!S.next(0, cur)) return;
    f32x4 acc[2][2][4][2];
#pragma unroll
    for (int a = 0; a < 2; ++a)
#pragma unroll
        for (int b = 0; b < 2; ++b)
#pragma unroll
            for (int m = 0; m < 4; ++m)
#pragma unroll
                for (int n = 0; n < 2; ++n) acc[a][b][m][n] = (f32x4){0.f, 0.f, 0.f, 0.f};
    bf16x8 At[4][2], B0[2][2], B1[2][2];
    const char* cA = (const char*)g.A + (size_t)cur.pm * tstepA; const char* cB = (const char*)g.Bt + (size_t)cur.pn * tstepB;
    PG8_STAGE(PG8_SB(0, 0), cB, voffB); PG8_STAGE(PG8_SA(0, 0), cA, voffA); PG8_STAGE(PG8_SB(0, 1), cB + hstepB, voffB); PG8_STAGE(PG8_SA(0, 1), cA + hstepA, voffA);
    if (wr == 1) PG8_BAR;
    PG8_WAIT_V(4); PG8_BAR;
    PG8_STAGE(PG8_SB(1, 0), cB + kstep, voffB); PG8_STAGE(PG8_SA(1, 0), cA + kstep, voffA); PG8_STAGE(PG8_SB(1, 1), cB + hstepB + kstep, voffB);
    PG8_WAIT_V(6); PG8_BAR;
    for (;;) {
        const bool has_next = S.next(ui + 1, nxt);
        const char* nA = has_next ? (const char*)g.A + (size_t)nxt.pm * tstepA : cA; const char* nB = has_next ? (const char*)g.Bt + (size_t)nxt.pn * tstepB : cB;
        for (int t = 0; t < nt; t += 2) {
            const bool last = (t == nt - 2);
            const char* a1 = cA + (size_t)(t + 1) * kstep;
            const char* a2 = last ? nA : cA + (size_t)(t + 2) * kstep; const char* b2 = last ? nB : cB + (size_t)(t + 2) * kstep;
            const char* a3 = a2 + kstep; const char* b3 = b2 + kstep;
            PG8_LDB(B0, 0, 0); PG8_SCHED; PG8_LDA(At, 0, 0); PG8_STAGE(PG8_SA(1, 1), a1 + hstepA, voffA);
            PG8_WAIT_L(8); PG8_BAR; PG8_WAIT_L(0); PG8_MMA(0, 0, At, B0); PG8_BAR; PG8_SCHED;
            PG8_LDB(B1, 0, 1); PG8_STAGE(PG8_SB(0, 0), b2, voffB);
            PG8_BAR; PG8_WAIT_L(0); PG8_MMA(0, 1, At, B1); PG8_BAR;
            PG8_LDA(At, 0, 1); PG8_STAGE(PG8_SA(0, 0), a2, voffA);
            PG8_BAR; PG8_WAIT_L(0); PG8_MMA(1, 0, At, B0); PG8_BAR; PG8_SCHED;
            PG8_STAGE(PG8_SB(0, 1), b2 + hstepB, voffB);
            PG8_WAIT_V(6); PG8_BAR; PG8_MMA(1, 1, At, B1); PG8_BAR;
            PG8_LDB(B0, 1, 0); PG8_SCHED; PG8_LDA(At, 1, 0); PG8_STAGE(PG8_SA(0, 1), a2 + hstepA, voffA);
            PG8_WAIT_L(8); PG8_BAR; PG8_WAIT_L(0); PG8_MMA(0, 0, At, B0); PG8_BAR; PG8_SCHED;
            PG8_LDB(B1, 1, 1); PG8_STAGE(PG8_SB(1, 0), b3, voffB);
            PG8_BAR; PG8_WAIT_L(0); PG8_MMA(0, 1, At, B1); PG8_BAR;
            PG8_LDA(At, 1, 1); PG8_STAGE(PG8_SA(1, 0), a3, voffA);
            PG8_BAR; PG8_WAIT_L(0); PG8_MMA(1, 0, At, B0); PG8_BAR; PG8_SCHED;
            PG8_STAGE(PG8_SB(1, 1), b3 + hstepB, voffB);
            PG8_WAIT_V(6); PG8_BAR; PG8_MMA(1, 1, At, B1); PG8_BAR;
        }
        gemm_epilogue(g, acc, cur, wr, wc, fr, fq);
        if (!has_next) break;
#pragma unroll
        for (int a = 0; a < 2; ++a)
#pragma unroll
            for (int b = 0; b < 2; ++b)
#pragma unroll
                for (int m = 0; m < 4; ++m)
#pragma unroll
                    for (int n = 0; n < 2; ++n) acc[a][b][m][n] = (f32x4){0.f, 0.f, 0.f, 0.f};
        cur = nxt; cA = nA; cB = nB; ++ui;
    }
    PG8_WAIT_V(0);
    if (wr == 0) PG8_BAR;
    PG8_BAR;
#undef PG8_SA
#undef PG8_SB
#undef PG8_STAGE
#undef PG8_LDA
#undef PG8_LDB
#undef PG8_MMA
#undef PG8_WAIT_V
#undef PG8_WAIT_L
#undef PG8_BAR
#undef PG8_SCHED
}

DI void transpose_cvt(const float* src, int K, int N, int lds_src, bf16_t* dst, int ldd, float* tile, int bid, int nb) {
    const int tid = get_tid(); const int tk = K / 64, tn = (N + 63) / 64, T = tk * tn;
    const int kk0 = tid >> 4, n4 = (tid & 15) * 4;
    f32x4 c0 = (f32x4){0.f, 0.f, 0.f, 0.f}, c1 = c0;
    if (bid < T) { const int k0 = (bid % tk) * 64, n0 = (bid / tk) * 64;
        if (n0 + n4 < N) { c0 = *(const f32x4*)(src + (size_t)(k0 + kk0) * lds_src + n0 + n4); c1 = *(const f32x4*)(src + (size_t)(k0 + kk0 + 32) * lds_src + n0 + n4); } }
    for (int t = bid; t < T; t += nb) {
        const int k0 = (t % tk) * 64, n0 = (t / tk) * 64;
        tile[kk0 * 65 + n4] = c0[0]; tile[kk0 * 65 + n4 + 1] = c0[1]; tile[kk0 * 65 + n4 + 2] = c0[2]; tile[kk0 * 65 + n4 + 3] = c0[3];
        tile[(kk0 + 32) * 65 + n4] = c1[0]; tile[(kk0 + 32) * 65 + n4 + 1] = c1[1]; tile[(kk0 + 32) * 65 + n4 + 2] = c1[2]; tile[(kk0 + 32) * 65 + n4 + 3] = c1[3];
        f32x4 d0 = (f32x4){0.f, 0.f, 0.f, 0.f}, d1 = d0;
        { const int t2 = t + nb;
          if (t2 < T) { const int k2 = (t2 % tk) * 64, n2 = (t2 / tk) * 64;
              if (n2 + n4 < N) { d0 = *(const f32x4*)(src + (size_t)(k2 + kk0) * lds_src + n2 + n4); d1 = *(const f32x4*)(src + (size_t)(k2 + kk0 + 32) * lds_src + n2 + n4); } } }
        lds_barrier();
        { const int nn = tid >> 3, k8 = (tid & 7) * 8; float v[8];
#pragma unroll
            for (int j = 0; j < 8; ++j) v[j] = tile[(k8 + j) * 65 + nn];
            if (n0 + nn < N) *(u32x4*)(dst + (size_t)(n0 + nn) * ldd + k0 + k8) = pack8(v); }
        lds_barrier();
        c0 = d0; c1 = d1;
    }
}

DI void convert_weights(CP c, int l, float* tile, int bid, int nb, int mask) {
    unsigned char* ws = c->ws; const int tid = get_tid();
    const float* wukv = c->in[I_WUKV] + (size_t)l * 256 * 1024;
    if (mask & 1) {
        bf16_t* WinT = (bf16_t*)(ws + WS_WIN);
        const float* w_in = c->in[I_WIN] + (size_t)l * 1024 * 6856;
        transpose_cvt(w_in, 1024, 3784, 6856, WinT, 1024, tile, bid, nb);
        transpose_cvt(w_in + 3784, 1024, 3072, 6856, WinT + (size_t)NZ1 * 1024, 1024, tile, (bid + 64) % nb, nb);
        for (int i = bid * 512 + tid; i < 56 * 1024 / 8; i += nb * 512) *(u32x4*)(WinT + (size_t)3784 * 1024 + (size_t)i * 8) = (u32x4){0u, 0u, 0u, 0u};
        transpose_cvt(c->in[I_WUQ] + (size_t)l * 384 * 768, 384, 768, 768, (bf16_t*)(ws + WS_WUQ), 384, tile, (bid + 160) % nb, nb);
        for (int h = 0; h < 4; ++h) {
            transpose_cvt(wukv + h * 256, 256, 128, 1024, (bf16_t*)(ws + WS_WUK) + (size_t)h * 128 * 256, 256, tile, (bid + 200 + 16 * h) % nb, nb);
            transpose_cvt(wukv + h * 256 + 128, 256, 128, 1024, (bf16_t*)(ws + WS_WUV) + (size_t)h * 128 * 256, 256, tile, (bid + 208 + 16 * h) % nb, nb);
        }
        { const float* wuq = c->in[I_WUQ] + (size_t)l * 384 * 768; bf16_t* dst = (bf16_t*)(ws + WS_WQABS);
          for (int o = bid * 512 + tid; o < 1024 * 384; o += nb * 512) { const int n = o / 384, k = o % 384, h = n >> 8, j = n & 255;
              const f32x4* a = (const f32x4*)(wukv + (size_t)j * 1024 + h * 256); const f32x4* b = (const f32x4*)(wuq + (size_t)k * 768 + h * 192); float s = 0.f;
#pragma unroll 8
              for (int d = 0; d < 32; ++d) { const f32x4 x = a[d], y = b[d]; s += x[0] * y[0] + x[1] * y[1] + x[2] * y[2] + x[3] * y[3]; }
              dst[o] = f2bf(s); } }
    }
    if (mask & 2) {
        transpose_cvt(c->in[I_WUP] + (size_t)l * 1024 * 5632, 1024, 5632, 5632, (bf16_t*)(ws + WS_WUP), 1024, tile, (bid + 128) % nb, nb);
        transpose_cvt(c->in[I_WOUT] + (size_t)l * 1024 * 1024, 1024, 1024, 1024, (bf16_t*)(ws + WS_WOUT), 1024, tile, (bid + 32) % nb, nb);
        for (int i = 0; i < 3; ++i)
            transpose_cvt(c->in[I_WBR] + (size_t)(l * 3 + i) * 512 * 1024, 512, 1024, 1024, (bf16_t*)(ws + WS_WBR) + (size_t)i * 1024 * 512, 512, tile, (bid + 96 + 40 * i) % nb, nb);
        { const float* wb = c->in[I_WBR] + (size_t)(l * 3 + 2) * 512 * 1024; bf16_t* dst = (bf16_t*)(ws + WS_WBRC);
          for (int o = bid * 512 + tid; o < 1024 * 256; o += nb * 512) { const int k = o >> 8, n = (o & 255) * 4, h = k >> 8, j = k & 255;
              const float* a = wukv + (size_t)j * 1024 + h * 256 + 128; const float* b = wb + (size_t)(h * 128) * 1024 + n; f32x4 sacc = (f32x4){0.f, 0.f, 0.f, 0.f};
#pragma unroll 16
              for (int cc = 0; cc < 128; ++cc) sacc += *(const f32x4*)(b + (size_t)cc * 1024) * a[cc];
#pragma unroll
              for (int q = 0; q < 4; ++q) dst[(size_t)(n + q) * 1024 + k] = f2bf(sacc[q]); } }
    }
    if (mask & 4)
        transpose_cvt(c->in[I_WDN] + (size_t)l * 2816 * 1024, 2816, 1024, 1024, (bf16_t*)(ws + WS_WDN), 2816, tile, (bid + 192) % nb, nb);
}

DI void prep_once(CP c, float* tile, int bid, int nb) {
    unsigned char* ws = c->ws; const int tid = get_tid();
    for (int l = 0; l < 2; ++l)
        transpose_cvt(c->in[I_WADA] + (size_t)l * 1024 * 6144, 1024, 6144, 6144, (bf16_t*)(ws + WS_WADA) + (size_t)l * 6144 * 1024, 1024, tile, (bid + 128 * l) % nb, nb);
    bf16_t* SC = (bf16_t*)(ws + WS_SC);
    for (int i = bid * 512 + tid; i < 256 * 1024; i += nb * 512) { const int r = i >> 10, k = i & 1023; float v = 0.f;
        if (r == 0) v = silu(c->in[I_CP][k]); else if (r <= 32) v = silu(c->in[I_CS][(r - 1) * 1024 + k]);
        SC[i] = f2bf(v); }
    float* rope = (float*)(ws + WS_ROPE);
    for (int i = bid * 512 + tid; i < 16384 * 32; i += nb * 512) { const int pos = i >> 5, f = i & 31;
        const float invf = exp2f(-(float)f * 0.41524101186092029f); const float ang = (float)pos * invf;
        const double a = (double)ang; const double kq = rint(a * 0.15915494309189535); const float rr = (float)(a - kq * 6.283185307179586);
        rope[2 * i] = __cosf(rr); rope[2 * i + 1] = __sinf(rr); }
}

DI void ln_pass(CP c, int mode, const float* gam, const float* bet, const float* modsc, const float* modsh, int bid, int nb, bool fin) {
    const int tid = get_tid(), lane = tid & 63, wave = tid >> 6;
    bf16_t* XB = (bf16_t*)(c->ws + WS_XB); bf16_t* H = (bf16_t*)(c->ws + WS_H);
    for (int r = bid * 8 + wave; r < MT; r += nb * 8) {
        f32x4 v[4];
        if (mode == 0) { const float* src = r < MP ? c->in[I_XP] + (size_t)r * DM : c->in[I_XS] + (size_t)(r - MP) * DM;
#pragma unroll
            for (int i = 0; i < 4; ++i) v[i] = *(const f32x4*)(src + lane * 4 + 256 * i); }
        else {
#pragma unroll
            for (int i = 0; i < 4; ++i) { const u32x2 w = *(const u32x2*)(XB + (size_t)r * DM + lane * 4 + 256 * i); v[i] = (f32x4){lo16(w.x), hi16(w.x), lo16(w.y), hi16(w.y)}; } }
        if (mode != 1) {
            float s = 0.f;
#pragma unroll
            for (int i = 0; i < 4; ++i) s += v[i][0] + v[i][1] + v[i][2] + v[i][3];
            const float mean = wave_sum(s) * (1.f / 1024.f); float q = 0.f;
#pragma unroll
            for (int i = 0; i < 4; ++i) { const f32x4 d = v[i] - mean; q += d[0] * d[0] + d[1] * d[1] + d[2] * d[2] + d[3] * d[3]; }
            const float rstd = rsqrtf(wave_sum(q) * (1.f / 1024.f) + 1e-5f);
#pragma unroll
            for (int i = 0; i < 4; ++i) { const int col = lane * 4 + 256 * i; const f32x4 g = *(const f32x4*)(gam + col), b = *(const f32x4*)(bet + col);
                v[i] = (v[i] - mean) * rstd * g + b;
                if (fin) *(f32x4*)(c->out + (size_t)r * DM + col) = v[i];
                else { u32x2 w; w.x = pk2(v[i][0], v[i][1]); w.y = pk2(v[i][2], v[i][3]); *(u32x2*)(XB + (size_t)r * DM + col) = w; } }
        }
        if (modsc) { const int mr = modrow_of(r);
#pragma unroll
            for (int i = 0; i < 4; ++i) { const int col = lane * 4 + 256 * i; const f32x4 sc = *(const f32x4*)(modsc + (size_t)mr * 12288 + col), sh = *(const f32x4*)(modsh + (size_t)mr * 12288 + col);
                const f32x4 h = v[i] * (sc + 1.0f) + sh; u32x2 w; w.x = pk2(h[0], h[1]); w.y = pk2(h[2], h[3]);
                *(u32x2*)(H + (size_t)r * DM + col) = w; } }
    }
}

DI void mla_row(CP c, int l, int r, int lane) {
    unsigned char* ws = c->ws; const bf16_t* z = (const bf16_t*)(ws + WS_Z1) + (size_t)r * NZ1;
    const bool samp = r >= MP; const int b = (r - MP) >> 4, t = (r - MP) & 15;
    {
        float v[8]; float ss = 0.f;
        if (lane < 48) { unpack8(*(const u32x4*)(z + 3080 + lane * 8), v);
#pragma unroll
            for (int j = 0; j < 8; ++j) ss += v[j] * v[j]; }
        const float rs = rsqrtf(wave_sum(ss) * (1.f / 384.f) + 1e-6f);
        if (lane < 48) { const float* g = c->in[I_QNG] + l * 384 + lane * 8;
#pragma unroll
            for (int j = 0; j < 8; ++j) v[j] = v[j] * rs * g[j];
            *(u32x4*)((bf16_t*)(ws + WS_QN) + (size_t)r * 384 + lane * 8) = pack8(v); }
    }
    {
        float v[8]; float ss = 0.f;
        if (lane < 32) { unpack8(*(const u32x4*)(z + 3464 + lane * 8), v);
#pragma unroll
            for (int j = 0; j < 8; ++j) ss += v[j] * v[j]; }
        const float rs = rsqrtf(wave_sum(ss) * (1.f / 256.f) + 1e-6f);
        if (lane < 32) { const float* g = c->in[I_KVNG] + l * 256 + lane * 8;
#pragma unroll
            for (int j = 0; j < 8; ++j) v[j] = v[j] * rs * g[j];
            *(u32x4*)((bf16_t*)(ws + WS_LAT) + (size_t)r * 256 + lane * 8) = pack8(v);
            float* o = samp ? c->out + O_SLAT + ((size_t)(l * 32 + b) * 16 + t) * 256 + lane * 8 : c->out + O_PLAT + ((size_t)l * MP + r) * 256 + lane * 8;
            *(f32x4*)o = (f32x4){v[0], v[1], v[2], v[3]}; *(f32x4*)(o + 4) = (f32x4){v[4], v[5], v[6], v[7]};
            if (samp) { bf16_t* lt = (bf16_t*)(ws + WS_LATT) + ((size_t)b * 256 + lane * 8) * LTS + 2048 + t;
#pragma unroll
                for (int j = 0; j < 8; ++j) lt[(size_t)j * LTS] = f2bf(v[j]); } }
    }
    if (lane < 32) {
        const float x1 = bf2f(z[3720 + lane]), x2 = bf2f(z[3752 + lane]); const int pos = samp ? 2048 + t : r;
        const float* cs = (const float*)(ws + WS_ROPE) + ((size_t)pos * 32 + lane) * 2; const float co = cs[0], si = cs[1];
        const float o1 = x1 * co - x2 * si, o2 = x2 * co + x1 * si;
        bf16_t* kp = (bf16_t*)(ws + WS_KPE) + (size_t)r * 64; kp[lane] = f2bf(o1); kp[32 + lane] = f2bf(o2);
        float* o = samp ? c->out + O_SKPE + ((size_t)(l * 32 + b) * 16 + t) * 64 : c->out + O_PKPE + ((size_t)l * MP + r) * 64;
        o[lane] = o1; o[32 + lane] = o2;
    }
    {
        float v[8]; unpack8(*(const u32x4*)(z + 2560 + lane * 8), v);
#pragma unroll
        for (int j = 0; j < 8; ++j) v[j] = silu(v[j]);
        *(u32x4*)((bf16_t*)(ws + WS_SZ) + (size_t)r * 512 + lane * 8) = pack8(v);
    }
    float* gco = nullptr;
    if (!samp && r >= MP - 3) gco = c->out + O_PGC + ((size_t)l * 3 + (r - (MP - 3))) * 1536;
    if (samp && t >= 13) gco = c->out + O_SGC + ((size_t)(l * 32 + b) * 3 + (t - 13)) * 1536;
    if (gco) for (int i = 0; i < 24; ++i) gco[lane + 64 * i] = bf2f(z[1024 + lane + 64 * i]);
}

DI void conva_tile(CP c, int l, int tile, float* U) {
    unsigned char* ws = c->ws; const int tid = get_tid(), ch = tid, lane = tid & 63, wave = tid >> 6;
    const bool samp = tile >= 512; const int b = tile - 512; const int RT = samp ? 16 : 32; const int t0 = samp ? 0 : tile * 32; const int rbase = samp ? MP + b * 16 : 0;
    const bf16_t* Z1 = (const bf16_t*)(ws + WS_Z1);
#pragma unroll 4
    for (int v = tid; v < (RT + 30) * 64; v += 512) { const int i = v >> 6, c8 = (v & 63) * 8; const int t = t0 - 30 + i; float u[8];
        if (t < 0) {
            if (samp) { const float* hp = c->in[I_SCA] + ((size_t)(l * 32 + b) * 30 + (30 + t)) * 512 + c8; const f32x4 a = *(const f32x4*)hp, bq = *(const f32x4*)(hp + 4);
                u[0] = a[0]; u[1] = a[1]; u[2] = a[2]; u[3] = a[3]; u[4] = bq[0]; u[5] = bq[1]; u[6] = bq[2]; u[7] = bq[3]; }
            else {
#pragma unroll
                for (int j = 0; j < 8; ++j) u[j] = 0.f; }
        } else { const bf16_t* z = Z1 + (size_t)(rbase + t) * NZ1 + c8; float a[8], gt[8]; unpack8(*(const u32x4*)z, a); unpack8(*(const u32x4*)(z + 512), gt);
#pragma unroll
            for (int j = 0; j < 8; ++j) u[j] = a[j] * sigm(gt[j]); }
        *(f32x4*)(U + i * 512 + c8) = (f32x4){u[0], u[1], u[2], u[3]}; *(f32x4*)(U + i * 512 + c8 + 4) = (f32x4){u[4], u[5], u[6], u[7]}; }
    lds_barrier();
    if (samp) { for (int j = 0; j < 30; ++j) c->out[O_SCA + ((size_t)(l * 32 + b) * 30 + j) * 512 + ch] = U[(16 + j) * 512 + ch]; }
    else if (tile == 511) { for (int j = 0; j < 30; ++j) c->out[O_PCA + ((size_t)l * 30 + j) * 512 + ch] = U[(32 + j) * 512 + ch]; }
    float w[31];
#pragma unroll
    for (int i = 0; i < 31; ++i) w[i] = c->in[I_CAW][((size_t)l * 31 + i) * 512 + ch];
    const float bias = c->in[I_CAB][l * 512 + ch];
#pragma unroll 1
    for (int tt = 0; tt < RT; ++tt) { float acc = bias;
#pragma unroll
        for (int i = 0; i < 31; ++i) acc += w[i] * U[(tt + i) * 512 + ch];
        U[tt * 512 + ch] = acc; }
    lds_barrier();
    {
        float v[4][8], sm[4], qv[4];
#pragma unroll
        for (int k = 0; k < 4; ++k) { const int tt = wave + 8 * k; sm[k] = 0.f;
            if (tt < RT) { const f32x4 a = *(const f32x4*)(U + tt * 512 + lane * 8), bq = *(const f32x4*)(U + tt * 512 + lane * 8 + 4);
                v[k][0] = a[0]; v[k][1] = a[1]; v[k][2] = a[2]; v[k][3] = a[3]; v[k][4] = bq[0]; v[k][5] = bq[1]; v[k][6] = bq[2]; v[k][7] = bq[3]; }
            else {
#pragma unroll
                for (int j = 0; j < 8; ++j) v[k][j] = 0.f; }
#pragma unroll
            for (int j = 0; j < 8; ++j) sm[k] += v[k][j]; }
#pragma unroll
        for (int o = 32; o >= 1; o >>= 1)
#pragma unroll
            for (int k = 0; k < 4; ++k) sm[k] += __shfl_xor(sm[k], o);
#pragma unroll
        for (int k = 0; k < 4; ++k) { sm[k] *= (1.f / 512.f); qv[k] = 0.f;
#pragma unroll
            for (int j = 0; j < 8; ++j) { const float d = v[k][j] - sm[k]; qv[k] += d * d; } }
#pragma unroll
        for (int o = 32; o >= 1; o >>= 1)
#pragma unroll
            for (int k = 0; k < 4; ++k) qv[k] += __shfl_xor(qv[k], o);
        const float* g = c->in[I_LNAG] + l * 512 + lane * 8; const float* be = c->in[I_LNAB] + l * 512 + lane * 8;
#pragma unroll
        for (int k = 0; k < 4; ++k) { const int tt = wave + 8 * k;
            if (tt < RT) { const float rstd = rsqrtf(qv[k] * (1.f / 512.f) + 1e-5f); float o8[8];
#pragma unroll
                for (int j = 0; j < 8; ++j) o8[j] = silu((v[k][j] - sm[k]) * rstd * g[j] + be[j]);
                *(u32x4*)((bf16_t*)(ws + WS_YA) + (size_t)(rbase + t0 + tt) * 512 + lane * 8) = pack8(o8); } }
    }
    lds_barrier();
}

DI void gdn_chunk(CP c, int l, int item, float* sm) {
    unsigned char* ws = c->ws; const int tid = get_tid(), lane = tid & 63, wave = tid >> 6;
    float* Qs = sm; float* Ks = Qs + 64 * 132; float* R = Ks + 64 * 132; float* Ls = R + 64 * 260; float* gs = Ls + 64 * 68; float* bs = gs + 64;
    const bool samp = item >= 1024; const int h = item & 3; const int n = item >> 2; const int b = (item - 1024) >> 2;
    const int C = samp ? 16 : 64; const int rbase = samp ? MP + b * 16 : n * 64;
    const bf16_t* Z1 = (const bf16_t*)(ws + WS_Z1);
    if (tid < 384) {
        const int part = tid >> 7, cc = tid & 127, col = part * 512 + h * 128 + cc;
        const float* cw = c->in[I_GCW] + (size_t)l * 4 * 1536 + col; const float w0 = cw[0], w1 = cw[1536], w2 = cw[2 * 1536], w3 = cw[3 * 1536];
        float x0 = 0.f, x1 = 0.f, x2 = 0.f;
        if (samp) { const float* hs = c->in[I_SGC] + (size_t)(l * 32 + b) * 3 * 1536 + col; x0 = hs[0]; x1 = hs[1536]; x2 = hs[2 * 1536]; }
        else if (n > 0) { const bf16_t* zz = Z1 + (size_t)(rbase - 3) * NZ1 + 1024 + col; x0 = bf2f(zz[0]); x1 = bf2f(zz[NZ1]); x2 = bf2f(zz[2 * NZ1]); }
        float* dst = part == 0 ? Qs + cc : (part == 1 ? Ks + cc : R + cc); const int dstride = part == 2 ? 260 : 132;
        const bf16_t* zr = Z1 + (size_t)rbase * NZ1 + 1024 + col;
#pragma unroll 1
        for (int i0 = 0; i0 < 64; i0 += 32) {
            unsigned xr[32];
#pragma unroll
            for (int k = 0; k < 32; ++k) xr[k] = (i0 + k < C) ? (unsigned)zr[(size_t)(i0 + k) * NZ1] : 0u;
#pragma unroll
            for (int k = 0; k < 32; ++k) { float y = 0.f;
                if (i0 + k < C) { const float x3 = lo16(xr[k]); y = silu(w0 * x0 + w1 * x1 + w2 * x2 + w3 * x3); x0 = x1; x1 = x2; x2 = x3; }
                dst[(i0 + k) * dstride] = y; }
        }
    }
    if (wave == 7) {
        float beta = 0.f, g = 0.f;
        if (lane < C) { const bf16_t* z = Z1 + (size_t)(rbase + lane) * NZ1; beta = sigm(bf2f(z[3072 + h]));
            const float x = bf2f(z[3076 + h]) + c->in[I_DTB][l * 4 + h]; const float sp = fmaxf(x, 0.f) + log1pf(expf(-fabsf(x)));
            g = -expf(c->in[I_ALOG][l * 4 + h]) * sp; }
        for (int o = 1; o < 64; o <<= 1) { const float tv = __shfl_up(g, o); if (lane >= o) g += tv; }
        gs[lane] = g; bs[lane] = beta;
    }
    lds_barrier();
    {
        float* rows = (wave < 4) ? Qs + (wave * 16) * 132 : Ks + ((wave - 4) * 16) * 132; const float qsc = (wave < 4) ? 0.08838834764831845f : 1.f;
        float av[16], bv[16], ssv[16];
#pragma unroll
        for (int k = 0; k < 16; ++k) { av[k] = rows[k * 132 + lane]; bv[k] = rows[k * 132 + 64 + lane]; ssv[k] = av[k] * av[k] + bv[k] * bv[k]; }
#pragma unroll
        for (int o = 32; o >= 1; o >>= 1)
#pragma unroll
            for (int k = 0; k < 16; ++k) ssv[k] += __shfl_xor(ssv[k], o);
#pragma unroll
        for (int k = 0; k < 16; ++k) { const float sc = rsqrtf(ssv[k] + 1e-6f) * qsc; rows[k * 132 + lane] = av[k] * sc; rows[k * 132 + 64 + lane] = bv[k] * sc; }
    }
    lds_barrier();
    {
        const int i = tid >> 3, t7 = tid & 7; float kk[8], qk[8];
#pragma unroll
        for (int j = 0; j < 8; ++j) { kk[j] = 0.f; qk[j] = 0.f; }
        const int wv = __builtin_amdgcn_readfirstlane(wave); const int njj = (8 * wv < C) ? wv + 1 : 0;
        if (njj > 0) {
            for (int d4 = 0; d4 < 32; ++d4) { const f32x4 ki = *(const f32x4*)(Ks + i * 132 + d4 * 4), qi = *(const f32x4*)(Qs + i * 132 + d4 * 4);
#pragma unroll
                for (int jj = 0; jj < 8; ++jj) if (jj < njj) { const f32x4 kj = *(const f32x4*)(Ks + (t7 + 8 * jj) * 132 + d4 * 4);
                    kk[jj] += ki[0] * kj[0] + ki[1] * kj[1] + ki[2] * kj[2] + ki[3] * kj[3]; qk[jj] += qi[0] * kj[0] + qi[1] * kj[1] + qi[2] * kj[2] + qi[3] * kj[3]; } }
        }
        const float gi = gs[i], bi = bs[i]; bf16_t* qkrow = (bf16_t*)(ws + WS_QK) + ((size_t)item * 64 + i) * 64;
#pragma unroll
        for (int jj = 0; jj < 8; ++jj) { const int j = t7 + 8 * jj; const float dec = (j <= i) ? __expf(gi - gs[j]) : 0.f;
            Ls[j * 68 + i] = (j < i) ? bi * kk[jj] * dec : 0.f; qkrow[j] = f2bf((j <= i) ? qk[jj] * dec : 0.f); }
    }
    for (int e = tid; e < 64 * 128; e += 512) { const int i = e >> 7, cc = e & 127; const float bi = bs[i];
        R[i * 260 + cc] *= bi; R[i * 260 + 128 + cc] = Ks[i * 132 + cc] * bi * __expf(gs[i]); }
    lds_barrier();
    if (tid < 256) {
        const int col = tid;
#pragma unroll
        for (int i0 = 0; i0 < 64; i0 += 8) {
            if (i0 >= C) break;
            float acc[8];
#pragma unroll
            for (int r = 0; r < 8; ++r) acc[r] = R[(i0 + r) * 260 + col];
#pragma unroll 8
            for (int j = 0; j < i0; ++j) { const float xj = R[j * 260 + col]; const f32x4 la = *(const f32x4*)(Ls + j * 68 + i0), lb = *(const f32x4*)(Ls + j * 68 + i0 + 4);
                acc[0] -= la[0] * xj; acc[1] -= la[1] * xj; acc[2] -= la[2] * xj; acc[3] -= la[3] * xj;
                acc[4] -= lb[0] * xj; acc[5] -= lb[1] * xj; acc[6] -= lb[2] * xj; acc[7] -= lb[3] * xj; }
#pragma unroll
            for (int r = 1; r < 8; ++r)
#pragma unroll
                for (int r2 = 0; r2 < r; ++r2) acc[r] -= Ls[(i0 + r2) * 68 + i0 + r] * acc[r2];
#pragma unroll
            for (int r = 0; r < 8; ++r) R[(i0 + r) * 260 + col] = acc[r];
        }
    } else {
        const int t2 = tid - 256; const float glast = gs[63];
        for (int v = t2; v < 1024; v += 256) { const int i = v >> 4, c8 = (v & 15) * 8; const float e = __expf(gs[i]); float o[8];
#pragma unroll
            for (int j = 0; j < 8; ++j) o[j] = Qs[i * 132 + c8 + j] * e;
            *(u32x4*)((bf16_t*)(ws + WS_QD) + ((size_t)item * 64 + i) * 128 + c8) = pack8(o); }
        for (int v = t2; v < 1024; v += 256) { const int cc = v >> 3, i8 = (v & 7) * 8; float o[8];
#pragma unroll
            for (int j = 0; j < 8; ++j) o[j] = Ks[(i8 + j) * 132 + cc] * __expf(glast - gs[i8 + j]);
            *(u32x4*)((bf16_t*)(ws + WS_KDT) + ((size_t)item * 128 + cc) * 64 + i8) = pack8(o); }
        if (t2 == 0) ((float*)(ws + WS_EGL))[item] = __expf(glast);
    }
    lds_barrier();
    for (int v = tid; v < 2048; v += 512) { const int i = v >> 5, c8 = (v & 31) * 8; float o[8];
#pragma unroll
        for (int j = 0; j < 8; ++j) o[j] = R[i * 260 + c8 + j];
        bf16_t* dst = c8 < 128 ? (bf16_t*)(ws + WS_U) + ((size_t)item * 64 + i) * 128 + c8 : (bf16_t*)(ws + WS_W) + ((size_t)item * 64 + i) * 128 + (c8 - 128);
        *(u32x4*)dst = pack8(o); }
    lds_barrier();
}

DI void gdn_scan(CP c, int l, int seq, int h, int mode, unsigned char* sm) {
    unsigned char* ws = c->ws; const int tid = get_tid(), lane = tid & 63, w = tid >> 6, fr = lane & 15, fq = lane >> 4;
    bf16_t* Wt = (bf16_t*)sm;
    bf16_t* KDt = Wt + 2 * 64 * 136;
    bf16_t* VTs = KDt + 2 * 128 * 72;
    bf16_t* STs = VTs + 128 * 72;
    bf16_t* Ut = STs + 128 * 136;
    const bool samp = seq > 0; const int b = seq - 1; const int nsteps = samp ? 1 : 128; const bool amode = (mode == 3); const float uscale = amode ? 0.f : 1.f;
    const int n0 = (mode >= 2) ? 128 : 0;
    const int item0 = samp ? 1024 + b * 4 + h : h + 4 * n0;
    const bf16_t* Ug = (const bf16_t*)(ws + WS_U); const bf16_t* Wg = (const bf16_t*)(ws + WS_W);
    const bf16_t* KDTg = (const bf16_t*)(ws + WS_KDT); const float* EGL = (const float*)(ws + WS_EGL);
    bf16_t* SNg = samp ? (bf16_t*)(ws + WS_SNS) + (size_t)(b * 4 + h) * 16384 : (amode ? (bf16_t*)(ws + WS_XA) + (size_t)h * 16384 : (bf16_t*)(ws + WS_SNP) + (size_t)(h + 4 * n0) * 16384);
    float* sout = samp ? c->out + O_SGDN + ((size_t)(l * 32 + b) * 4 + h) * 16384 : c->out + O_PGDN + ((size_t)l * 4 + h) * 16384;
    f32x4 Sacc[8];
#pragma unroll
    for (int mt = 0; mt < 8; ++mt) {
        if (samp) { const float* sp = c->in[I_SGDN] + ((size_t)(l * 32 + b) * 4 + h) * 16384;
#pragma unroll
            for (int i = 0; i < 4; ++i) Sacc[mt][i] = sp[(16 * mt + 4 * fq + i) * 128 + 16 * w + fr]; }
        else {
#pragma unroll
            for (int i = 0; i < 4; ++i) Sacc[mt][i] = (amode && (16 * mt + 4 * fq + i == 16 * w + fr)) ? 1.f : 0.f; }
    }
    const u32x4 z4 = (u32x4){0u, 0u, 0u, 0u};
    u32x4 Pw0 = z4, Pw1 = z4, Pk0 = z4, Pk1 = z4, Qw0 = z4, Qw1 = z4, Qk0 = z4, Qk1 = z4, Pu0 = z4, Pu1 = z4, Qu0 = z4, Qu1 = z4; float Pe = 1.f, Qe = 1.f, egl = 1.f;
#define SC_ISSUE(X, it) do { const size_t _i = (size_t)(it); \
        X##w0 = *(const u32x4*)(Wg + _i * 8192 + (size_t)tid * 8); X##w1 = *(const u32x4*)(Wg + _i * 8192 + (size_t)(tid + 512) * 8); \
        X##k0 = *(const u32x4*)(KDTg + _i * 8192 + (size_t)tid * 8); X##k1 = *(const u32x4*)(KDTg + _i * 8192 + (size_t)(tid + 512) * 8); \
        X##u0 = *(const u32x4*)(Ug + _i * 8192 + (size_t)tid * 8); X##u1 = *(const u32x4*)(Ug + _i * 8192 + (size_t)(tid + 512) * 8); \
        X##e = EGL[_i]; } while (0)
#define SC_COMMIT(X, buf) do { bf16_t* _W = Wt + (buf) * 64 * 136; bf16_t* _K = KDt + (buf) * 128 * 72; bf16_t* _U = Ut + (buf) * 64 * 136; \
        { const int v = tid, r = v >> 4, sg = (v & 15) * 8; *(u32x4*)(_W + r * 136 + sg) = X##w0; *(u32x4*)(_U + r * 136 + sg) = X##u0; } \
        { const int v = tid + 512, r = v >> 4, sg = (v & 15) * 8; *(u32x4*)(_W + r * 136 + sg) = X##w1; *(u32x4*)(_U + r * 136 + sg) = X##u1; } \
        { const int v = tid, r = v >> 3, sg = (v & 7) * 8; *(u32x4*)(_K + r * 72 + sg) = X##k0; } \
        { const int v = tid + 512, r = v >> 3, sg = (v & 7) * 8; *(u32x4*)(_K + r * 72 + sg) = X##k1; } \
        egl = X##e; } while (0)
#define SC_STEP(X, n) do { const int _n = (n); const int _buf = _n & 1; const bf16_t* _W = Wt + _buf * 64 * 136; const bf16_t* _K = KDt + _buf * 128 * 72; const bf16_t* _U = Ut + _buf * 64 * 136; \
        bf16_t* _sn = SNg + (size_t)_n * 4 * 16384; \
        _Pragma("unroll") for (int mt = 0; mt < 8; ++mt) { u32x2 p; p.x = pk2(Sacc[mt][0], Sacc[mt][1]); p.y = pk2(Sacc[mt][2], Sacc[mt][3]); \
            *(u32x2*)(STs + (16 * w + fr) * 136 + 16 * mt + 4 * fq) = p; \
            if (!amode) *(u32x2*)(_sn + (size_t)(16 * w + fr) * 128 + 16 * mt + 4 * fq) = p; \
            else { bf16_t* _q = _sn + (size_t)(16 * mt + 4 * fq) * 128 + 16 * w + fr; _q[0] = (bf16_t)(p.x & 0xffffu); _q[128] = (bf16_t)(p.x >> 16); _q[256] = (bf16_t)(p.y & 0xffffu); _q[384] = (bf16_t)(p.y >> 16); } } \
        asm volatile("s_waitcnt lgkmcnt(0)" ::: "memory"); __builtin_amdgcn_wave_barrier(); \
        bf16x8 Sb[4]; bf16x8 Af[8]; bf16_t ucur[16]; \
        _Pragma("unroll") for (int mt = 0; mt < 4; ++mt) _Pragma("unroll") for (int i = 0; i < 4; ++i) ucur[mt * 4 + i] = _U[(16 * mt + 4 * fq + i) * 136 + 16 * w + fr]; \
        _Pragma("unroll") for (int s_ = 0; s_ < 4; ++s_) Sb[s_] = *(const bf16x8*)(STs + (16 * w + fr) * 136 + 32 * s_ + 8 * fq); \
        _Pragma("unroll") for (int hb = 0; hb < 2; ++hb) { \
            _Pragma("unroll") for (int m2 = 0; m2 < 2; ++m2) _Pragma("unroll") for (int s_ = 0; s_ < 4; ++s_) Af[m2 * 4 + s_] = *(const bf16x8*)(_W + (16 * (2 * hb + m2) + fr) * 136 + 32 * s_ + 8 * fq); \
            __builtin_amdgcn_sched_barrier(0); \
            _Pragma("unroll") for (int m2 = 0; m2 < 2; ++m2) { const int mt = 2 * hb + m2; f32x4 a = (f32x4){0.f, 0.f, 0.f, 0.f}; \
                _Pragma("unroll") for (int s_ = 0; s_ < 4; ++s_) a = __builtin_amdgcn_mfma_f32_16x16x32_bf16(Af[m2 * 4 + s_], Sb[s_], a, 0, 0, 0); \
                u32x2 p; p.x = pk2(uscale * bf2f(ucur[mt * 4 + 0]) - a[0], uscale * bf2f(ucur[mt * 4 + 1]) - a[1]); p.y = pk2(uscale * bf2f(ucur[mt * 4 + 2]) - a[2], uscale * bf2f(ucur[mt * 4 + 3]) - a[3]); \
                *(u32x2*)(VTs + (16 * w + fr) * 72 + 16 * mt + 4 * fq) = p; } \
            __builtin_amdgcn_sched_barrier(0); } \
        _Pragma("unroll") for (int m2 = 0; m2 < 4; ++m2) _Pragma("unroll") for (int s_ = 0; s_ < 2; ++s_) Af[m2 * 2 + s_] = *(const bf16x8*)(_K + (16 * m2 + fr) * 72 + 32 * s_ + 8 * fq); \
        asm volatile("s_waitcnt lgkmcnt(0)" ::: "memory"); __builtin_amdgcn_wave_barrier(); \
        bf16x8 Vb[2]; \
        _Pragma("unroll") for (int s_ = 0; s_ < 2; ++s_) Vb[s_] = *(const bf16x8*)(VTs + (16 * w + fr) * 72 + 32 * s_ + 8 * fq); \
        _Pragma("unroll") for (int hb = 0; hb < 2; ++hb) { \
            if (hb == 1) { _Pragma("unroll") for (int m2 = 0; m2 < 4; ++m2) _Pragma("unroll") for (int s_ = 0; s_ < 2; ++s_) Af[m2 * 2 + s_] = *(const bf16x8*)(_K + (16 * (4 + m2) + fr) * 72 + 32 * s_ + 8 * fq); } \
            __builtin_amdgcn_sched_barrier(0); \
            _Pragma("unroll") for (int m2 = 0; m2 < 4; ++m2) { const int mt = 4 * hb + m2; f32x4 a = Sacc[mt] * egl; \
                _Pragma("unroll") for (int s_ = 0; s_ < 2; ++s_) a = __builtin_amdgcn_mfma_f32_16x16x32_bf16(Af[m2 * 2 + s_], Vb[s_], a, 0, 0, 0); \
                Sacc[mt] = a; } \
            __builtin_amdgcn_sched_barrier(0); } \
        SC_COMMIT(X, _buf ^ 1); \
        if (_n + 3 < nsteps) SC_ISSUE(X, item0 + 4 * (_n + 3)); \
        lds_barrier(); } while (0)
    lds_barrier();
    SC_ISSUE(Q, item0); SC_COMMIT(Q, 0);
    if (nsteps > 1) { SC_ISSUE(P, item0 + 4); SC_ISSUE(Q, item0 + 8); }
    lds_barrier();
    for (int n = 0; n < nsteps; n += 2) {
        SC_STEP(P, n);
        if (n + 1 < nsteps) SC_STEP(Q, n + 1);
    }
#undef SC_ISSUE
#undef SC_COMMIT
#undef SC_STEP
    if (mode == 0 || mode == 2) {
#pragma unroll
        for (int mt = 0; mt < 8; ++mt)
#pragma unroll
            for (int i = 0; i < 4; ++i) sout[(16 * mt + 4 * fq + i) * 128 + 16 * w + fr] = Sacc[mt][i];
    } else if (mode == 1) {
        bf16_t* x = (bf16_t*)(ws + WS_XS128) + (size_t)h * 16384;
#pragma unroll
        for (int mt = 0; mt < 8; ++mt) { u32x2 p; p.x = pk2(Sacc[mt][0], Sacc[mt][1]); p.y = pk2(Sacc[mt][2], Sacc[mt][3]); *(u32x2*)(x + (size_t)(16 * w + fr) * 128 + 16 * mt + 4 * fq) = p; }
    } else {
        bf16_t* x = (bf16_t*)(ws + WS_XA256) + (size_t)h * 16384;
#pragma unroll
        for (int mt = 0; mt < 8; ++mt)
#pragma unroll
            for (int i = 0; i < 4; ++i) x[(size_t)(16 * mt + 4 * fq + i) * 128 + 16 * w + fr] = f2bf(Sacc[mt][i]);
    }
    lds_barrier();
}

DI void gdn_out(CP c, int l, int item, unsigned char* sm) {
    unsigned char* ws = c->ws; const int tid = get_tid(), lane = tid & 63, w = tid >> 6, fr = lane & 15, fq = lane >> 4;
    bf16_t* Ws = (bf16_t*)sm; bf16_t* QDs = Ws + 64 * 136; bf16_t* QKs = QDs + 64 * 136; bf16_t* VTs = QKs + 64 * 72; bf16_t* STs = VTs + 128 * 72;
    float* OS = (float*)(STs + 128 * 136);
    const bool samp = item >= 1024; const int h = item & 3, n = item >> 2, b = (item - 1024) >> 2; const int C = samp ? 16 : 64;
    const bf16_t* Ug = (const bf16_t*)(ws + WS_U) + (size_t)item * 8192; const bf16_t* Wg = (const bf16_t*)(ws + WS_W) + (size_t)item * 8192;
    const bf16_t* QDg = (const bf16_t*)(ws + WS_QD) + (size_t)item * 8192; const bf16_t* QKg = (const bf16_t*)(ws + WS_QK) + (size_t)item * 4096;
    const bf16_t* SNg = samp ? (const bf16_t*)(ws + WS_SNS) + (size_t)(item - 1024) * 16384 : (const bf16_t*)(ws + WS_SNP) + (size_t)item * 16384;
    const bool fin = item >= NITEM_GDN;
    const bool comb = fin || (!samp && n >= 128);
    if (comb) {
        const int hh = fin ? item - NITEM_GDN : h;
        const bf16_t* XAg = fin ? (const bf16_t*)(ws + WS_XA256) + (size_t)hh * 16384 : (const bf16_t*)(ws + WS_XA) + (size_t)((n - 128) * 4 + h) * 16384;
        const bf16_t* XSg = (const bf16_t*)(ws + WS_XS128) + (size_t)hh * 16384;
        bf16_t* As = Ws; bf16_t* S8s = (bf16_t*)OS;
#pragma unroll
        for (int k = 0; k < 4; ++k) { const int v = tid + 512 * k, r = v >> 4, sg = (v & 15) * 8;
            *(u32x4*)(As + r * 136 + sg) = *(const u32x4*)(XAg + (size_t)v * 8); *(u32x4*)(S8s + r * 136 + sg) = *(const u32x4*)(XSg + (size_t)v * 8); }
        lds_barrier();
        bf16x8 Bf[4];
#pragma unroll
        for (int s2 = 0; s2 < 4; ++s2) Bf[s2] = *(const bf16x8*)(S8s + (16 * w + fr) * 136 + 32 * s2 + 8 * fq);
#pragma unroll
        for (int mt = 0; mt < 8; ++mt) { f32x4 a = (f32x4){0.f, 0.f, 0.f, 0.f};
#pragma unroll
            for (int s2 = 0; s2 < 4; ++s2) a = __builtin_amdgcn_mfma_f32_16x16x32_bf16(*(const bf16x8*)(As + (16 * mt + fr) * 136 + 32 * s2 + 8 * fq), Bf[s2], a, 0, 0, 0);
            if (fin) { float* o = c->out + O_PGDN + ((size_t)l * 4 + hh) * 16384;
#pragma unroll
                for (int i = 0; i < 4; ++i) o[(16 * mt + 4 * fq + i) * 128 + 16 * w + fr] += a[i]; }
            else { const u32x2 bb = *(const u32x2*)(SNg + (size_t)(16 * w + fr) * 128 + 16 * mt + 4 * fq);
                u32x2 p; p.x = pk2(a[0] + lo16(bb.x), a[1] + hi16(bb.x)); p.y = pk2(a[2] + lo16(bb.y), a[3] + hi16(bb.y));
                *(u32x2*)(STs + (16 * w + fr) * 136 + 16 * mt + 4 * fq) = p; }
            asm volatile("" ::: "memory"); }
        lds_barrier();
        if (fin) return;
    }
#pragma unroll
    for (int k = 0; k < 2; ++k) { const int v = tid + 512 * k, r = v >> 4, sg = (v & 15) * 8;
        *(u32x4*)(Ws + r * 136 + sg) = *(const u32x4*)(Wg + (size_t)v * 8); *(u32x4*)(QDs + r * 136 + sg) = *(const u32x4*)(QDg + (size_t)v * 8); }
    { const int v = tid, r = v >> 3, sg = (v & 7) * 8; *(u32x4*)(QKs + r * 72 + sg) = *(const u32x4*)(QKg + (size_t)v * 8); }
    if (!comb) {
#pragma unroll
        for (int k = 0; k < 4; ++k) { const int v = tid + 512 * k, r = v >> 4, sg = (v & 15) * 8; *(u32x4*)(STs + r * 136 + sg) = *(const u32x4*)(SNg + (size_t)v * 8); }
    }
    float uu[16];
#pragma unroll
    for (int mt = 0; mt < 4; ++mt)
#pragma unroll
        for (int i = 0; i < 4; ++i) uu[mt * 4 + i] = bf2f(Ug[(size_t)(16 * mt + 4 * fq + i) * 128 + 16 * w + fr]);
    unsigned zg[16];
#pragma unroll
    for (int k = 0; k < 8; ++k) { const int i = w * 8 + k; const int r = samp ? MP + b * 16 + (i < C ? i : 0) : n * 64 + i;
        const bf16_t* sz = (const bf16_t*)(ws + WS_SZ) + (size_t)r * 512 + h * 128; zg[2 * k] = (unsigned)sz[lane]; zg[2 * k + 1] = (unsigned)sz[64 + lane]; }
    lds_barrier();
    bf16x8 Sb[4];
#pragma unroll
    for (int s = 0; s < 4; ++s) Sb[s] = *(const bf16x8*)(STs + (16 * w + fr) * 136 + 32 * s + 8 * fq);
#pragma unroll
    for (int mt = 0; mt < 4; ++mt) { f32x4 a = (f32x4){0.f, 0.f, 0.f, 0.f};
#pragma unroll
        for (int s = 0; s < 4; ++s) a = __builtin_amdgcn_mfma_f32_16x16x32_bf16(*(const bf16x8*)(Ws + (16 * mt + fr) * 136 + 32 * s + 8 * fq), Sb[s], a, 0, 0, 0);
        u32x2 p; p.x = pk2(uu[mt * 4 + 0] - a[0], uu[mt * 4 + 1] - a[1]); p.y = pk2(uu[mt * 4 + 2] - a[2], uu[mt * 4 + 3] - a[3]);
        *(u32x2*)(VTs + (16 * w + fr) * 72 + 16 * mt + 4 * fq) = p; asm volatile("" ::: "memory"); }
    asm volatile("s_waitcnt lgkmcnt(0)" ::: "memory"); __builtin_amdgcn_wave_barrier();
    bf16x8 Vb[2];
#pragma unroll
    for (int s = 0; s < 2; ++s) Vb[s] = *(const bf16x8*)(VTs + (16 * w + fr) * 72 + 32 * s + 8 * fq);
#pragma unroll
    for (int mt = 0; mt < 4; ++mt) { f32x4 o = (f32x4){0.f, 0.f, 0.f, 0.f};
#pragma unroll
        for (int s = 0; s < 4; ++s) o = __builtin_amdgcn_mfma_f32_16x16x32_bf16(*(const bf16x8*)(QDs + (16 * mt + fr) * 136 + 32 * s + 8 * fq), Sb[s], o, 0, 0, 0);
#pragma unroll
        for (int s = 0; s < 2; ++s) o = __builtin_amdgcn_mfma_f32_16x16x32_bf16(*(const bf16x8*)(QKs + (16 * mt + fr) * 72 + 32 * s + 8 * fq), Vb[s], o, 0, 0, 0);
#pragma unroll
        for (int i = 0; i < 4; ++i) OS[(16 * mt + 4 * fq + i) * 132 + 16 * w + fr] = o[i];
        asm volatile("" ::: "memory"); }
    lds_barrier();
    const float gn0 = c->in[I_GNG][l * 128 + lane], gn1 = c->in[I_GNG][l * 128 + 64 + lane];
    if (w * 8 < C) {
        float av[8], bv[8], ssv[8];
#pragma unroll
        for (int k = 0; k < 8; ++k) { const int i = w * 8 + k; av[k] = OS[i * 132 + lane]; bv[k] = OS[i * 132 + 64 + lane]; ssv[k] = av[k] * av[k] + bv[k] * bv[k]; }
#pragma unroll
        for (int o = 32; o >= 1; o >>= 1)
#pragma unroll
            for (int k = 0; k < 8; ++k) ssv[k] += __shfl_xor(ssv[k], o);
#pragma unroll
        for (int k = 0; k < 8; ++k) { const int i = w * 8 + k; const int r = samp ? MP + b * 16 + i : n * 64 + i;
            const float rs = rsqrtf(ssv[k] * (1.f / 128.f) + 1e-6f);
            bf16_t* yb = (bf16_t*)(ws + WS_YB) + (size_t)r * 512 + h * 128;
            yb[lane] = f2bf(av[k] * rs * gn0 * lo16(zg[2 * k])); yb[64 + lane] = f2bf(bv[k] * rs * gn1 * lo16(zg[2 * k + 1])); }
    }
    lds_barrier();
}

template <int DK, int DV, int KT, bool SAMPLE>
DI void attn_item(CP c, int l, int qb, int h, unsigned char* sm) {
    constexpr int NQ = SAMPLE ? 64 : 128, QS = DK + 8, VS = KT + 8, NMT = KT / 32, NDT = DV / 32;
    unsigned char* ws = c->ws; const int tid = get_tid(), lane = tid & 63, w = tid >> 6, g = w >> 2, wq = w & 3, l31 = lane & 31, hh = lane >> 5, gt = tid & 255;
    bf16_t* Qs = (bf16_t*)sm; bf16_t* Ks = Qs + NQ * QS + g * (KT * QS + DV * VS); bf16_t* Vs = Ks + KT * QS;
    float* Ex = (float*)(Qs + NQ * QS);
    const bf16_t* Qg = (const bf16_t*)(ws + WS_Q); const bf16_t* KNg = (const bf16_t*)(ws + WS_KN); const bf16_t* KPEg = (const bf16_t*)(ws + WS_KPE);
    const bf16_t* VTg = (const bf16_t*)(ws + WS_VT); const bf16_t* LATg = (const bf16_t*)(ws + WS_LAT); const bf16_t* LTg = (const bf16_t*)(ws + WS_LATT);
    const float* rope = (const float*)(ws + WS_ROPE);
    const int b = qb;
    lds_barrier();
    if (!SAMPLE) {
        for (int v = tid; v < 128 * 24; v += 512) { const int r = v / 24, s = v % 24; *(u32x4*)(Qs + r * QS + s * 8) = *(const u32x4*)(Qg + (size_t)(qb * 128 + r) * 768 + h * 192 + s * 8); }
    } else {
        const bf16_t* QAg = (const bf16_t*)(ws + WS_QABS);
        for (int v = tid; v < 64 * 40; v += 512) { const int r = v / 40, s = v % 40, hq = r >> 4, t = r & 15;
            const bf16_t* src = s < 32 ? QAg + (size_t)(b * 16 + t) * 1024 + hq * 256 + s * 8 : Qg + (size_t)(MP + b * 16 + t) * 768 + hq * 192 + 128 + (s - 32) * 8;
            *(u32x4*)(Qs + r * QS + s * 8) = *(const u32x4*)src; }
    }
    lds_barrier();
    for (int v = tid; v < NQ * 32; v += 512) { const int r = v >> 5, f = v & 31; const int pos = SAMPLE ? 2048 + (r & 15) : qb * 128 + r;
        const float co = rope[((size_t)pos * 32 + f) * 2], si = rope[((size_t)pos * 32 + f) * 2 + 1];
        bf16_t* q = Qs + r * QS + (DK - 64); const float x1 = bf2f(q[f]), x2 = bf2f(q[32 + f]);
        q[f] = f2bf(x1 * co - x2 * si); q[32 + f] = f2bf(x2 * co + x1 * si); }
    constexpr bool QREG = false;
    bf16x8 Qf[QREG ? DK / 16 : 1];
    if (QREG) { lds_barrier();
#pragma unroll
        for (int ks = 0; ks < (QREG ? DK / 16 : 1); ++ks) Qf[ks] = *(const bf16x8*)(Qs + (32 * wq + l31) * QS + 16 * ks + 8 * hh); }
    const int ntiles = SAMPLE ? 66 : 2 * qb + 2; const int nj = ntiles / 2;
    const bool wave_on = SAMPLE ? (wq < 2) : true;
    const int qc = 2 * qb + (wq >> 1);
    f32x16 Oacc[NDT];
#pragma unroll
    for (int d = 0; d < NDT; ++d)
#pragma unroll
        for (int i = 0; i < 16; ++i) Oacc[d][i] = 0.f;
    float m_run = -INFINITY, l_run = 0.f;
    const float scale = 0.07216878364870322f * 1.4426950408889634f;
    u32x4 kreg[6], vreg[4];
    const int lkey = gt >> 2, ls0 = gt & 3, ldv = gt >> 1, lv0 = gt & 1;
    const bf16_t* kn_base = KNg + (size_t)lkey * 512 + h * 128 + ls0 * 8; const bf16_t* kp_base = KPEg + (size_t)lkey * 64 + ls0 * 8;
    const bf16_t* vt_base = VTg + (size_t)(h * 128 + ldv) * MP + lv0 * 8;
#define ATT_ISSUE(kt) do { const size_t _k0 = (size_t)(kt) * 64; \
        _Pragma("unroll") for (int i = 0; i < 4; ++i) kreg[i] = *(const u32x4*)(kn_base + _k0 * 512 + i * 32); \
        _Pragma("unroll") for (int i = 0; i < 2; ++i) kreg[4 + i] = *(const u32x4*)(kp_base + _k0 * 64 + i * 32); \
        _Pragma("unroll") for (int i = 0; i < 4; ++i) vreg[i] = *(const u32x4*)(vt_base + _k0 + i * 16); } while (0)
    if (!SAMPLE) ATT_ISSUE(g);
    for (int j = 0; j < nj; ++j) {
        const int kt = 2 * j + g;
        lds_barrier();
        if (!SAMPLE) {
#pragma unroll
            for (int i = 0; i < 6; ++i) *(u32x4*)(Ks + lkey * QS + ls0 * 8 + i * 32) = kreg[i];
#pragma unroll
            for (int i = 0; i < 4; ++i) *(u32x4*)(Vs + ldv * VS + lv0 * 8 + i * 16) = vreg[i];
        } else {
            const int k0 = kt * 32;
            for (int v = gt; v < 32 * 40; v += 256) { const int key = v / 40, s = v % 40, kk = k0 + key; u32x4 o = (u32x4){0u, 0u, 0u, 0u};
                if (kk < 2048) { const float* src = s < 32 ? c->in[I_CLAT] + ((size_t)(l * 32 + b) * 2048 + kk) * 256 + s * 8 : c->in[I_CKPE] + ((size_t)(l * 32 + b) * 2048 + kk) * 64 + (s - 32) * 8;
                    const f32x4 a = *(const f32x4*)src, bq = *(const f32x4*)(src + 4); o.x = pk2(a[0], a[1]); o.y = pk2(a[2], a[3]); o.z = pk2(bq[0], bq[1]); o.w = pk2(bq[2], bq[3]); }
                else if (kk < 2064) { const int rr = MP + b * 16 + (kk - 2048); o = *(const u32x4*)(s < 32 ? LATg + (size_t)rr * 256 + s * 8 : KPEg + (size_t)rr * 64 + (s - 32) * 8); }
                *(u32x4*)(Ks + key * QS + s * 8) = o; }
            for (int v = gt; v < 256 * 4; v += 256) { const int dv = v >> 2, s = v & 3; u32x4 o = (u32x4){0u, 0u, 0u, 0u};
                if (k0 < LTS) o = *(const u32x4*)(LTg + ((size_t)b * 256 + dv) * LTS + k0 + s * 8);
                *(u32x4*)(Vs + dv * VS + s * 8) = o; }
        }
        lds_barrier();
        if (!SAMPLE) { if (j + 1 < nj) ATT_ISSUE(kt + 2); }
        const bool active = SAMPLE ? (wave_on && kt * 32 < 2064) : (kt <= qc);
        if (active) {
            f32x16 S[NMT];
#pragma unroll
            for (int mt = 0; mt < NMT; ++mt)
#pragma unroll
                for (int i = 0; i < 16; ++i) S[mt][i] = 0.f;
            {
                constexpr int NKP = DK / 32;
                bf16x8 Kf[2][2 * NMT]; bf16x8 Ql[2][2];
#pragma unroll
                for (int e = 0; e < 2; ++e) {
#pragma unroll
                    for (int mt = 0; mt < NMT; ++mt) Kf[0][e * NMT + mt] = *(const bf16x8*)(Ks + (32 * mt + l31) * QS + 16 * e + 8 * hh);
                    if (!QREG) Ql[0][e] = *(const bf16x8*)(Qs + (32 * wq + l31) * QS + 16 * e + 8 * hh); }
#pragma unroll
                for (int kp = 0; kp < NKP; ++kp) {
                    if (kp + 1 < NKP) {
#pragma unroll
                        for (int e = 0; e < 2; ++e) {
#pragma unroll
                            for (int mt = 0; mt < NMT; ++mt) Kf[(kp + 1) & 1][e * NMT + mt] = *(const bf16x8*)(Ks + (32 * mt + l31) * QS + 16 * (2 * kp + 2 + e) + 8 * hh);
                            if (!QREG) Ql[(kp + 1) & 1][e] = *(const bf16x8*)(Qs + (32 * wq + l31) * QS + 16 * (2 * kp + 2 + e) + 8 * hh); } }
                    __builtin_amdgcn_sched_barrier(0);
#pragma unroll
                    for (int e = 0; e < 2; ++e)
#pragma unroll
                        for (int mt = 0; mt < NMT; ++mt) S[mt] = __builtin_amdgcn_mfma_f32_32x32x16_bf16(Kf[kp & 1][e * NMT + mt], !QREG ? Ql[kp & 1][e] : Qf[QREG ? 2 * kp + e : 0], S[mt], 0, 0, 0);
                    __builtin_amdgcn_sched_barrier(0);
                }
            }
            float mloc = -INFINITY;
#pragma unroll
            for (int mt = 0; mt < NMT; ++mt)
#pragma unroll
                for (int i = 0; i < 16; ++i) { float s = S[mt][i] * scale;
                    if (SAMPLE) { const int key = kt * KT + 32 * mt + (i & 3) + 8 * (i >> 2) + 4 * hh; if (key >= 2064) s = -INFINITY; }
                    S[mt][i] = s; mloc = fmaxf(mloc, s); }
            mloc = fmaxf(mloc, __shfl_xor(mloc, 32));
            const float mnew = fmaxf(m_run, mloc); const float alpha = __builtin_amdgcn_exp2f(m_run - mnew); float psum = 0.f;
#pragma unroll
            for (int mt = 0; mt < NMT; ++mt)
#pragma unroll
                for (int i = 0; i < 16; ++i) { const float p = __builtin_amdgcn_exp2f(S[mt][i] - mnew); S[mt][i] = p; psum += p; }
            l_run = l_run * alpha + psum; m_run = mnew;
#pragma unroll
            for (int d = 0; d < NDT; ++d) Oacc[d] = Oacc[d] * alpha;
            {
                constexpr int NDB = NDT / 4;
                constexpr int NG = 2 * NMT * NDB;
                u32x4 Vf[2][4];
#define ATT_LDV(buf, gi) do { const int _kg = (gi) / NDB, _db = (gi) % NDB; _Pragma("unroll") for (int d = 0; d < 4; ++d) { const bf16_t* vp = Vs + (32 * (4 * _db + d) + l31) * VS + 16 * _kg + 4 * hh; \
                        const u32x2 lo = *(const u32x2*)vp, hi = *(const u32x2*)(vp + 8); Vf[buf][d].x = lo.x; Vf[buf][d].y = lo.y; Vf[buf][d].z = hi.x; Vf[buf][d].w = hi.y; } } while (0)
                ATT_LDV(0, 0);
#pragma unroll
                for (int gi = 0; gi < NG; ++gi) { const int kg = gi / NDB, db = gi % NDB, mt = kg >> 1, s2 = kg & 1;
                    if (gi + 1 < NG) ATT_LDV((gi + 1) & 1, gi + 1);
                    u32x4 pw; pw.x = pk2(S[mt][8 * s2 + 0], S[mt][8 * s2 + 1]); pw.y = pk2(S[mt][8 * s2 + 2], S[mt][8 * s2 + 3]);
                    pw.z = pk2(S[mt][8 * s2 + 4], S[mt][8 * s2 + 5]); pw.w = pk2(S[mt][8 * s2 + 6], S[mt][8 * s2 + 7]);
                    const bf16x8 pf = __builtin_bit_cast(bf16x8, pw);
                    __builtin_amdgcn_sched_barrier(0);
#pragma unroll
                    for (int d = 0; d < 4; ++d) Oacc[4 * db + d] = __builtin_amdgcn_mfma_f32_32x32x16_bf16(__builtin_bit_cast(bf16x8, Vf[gi & 1][d]), pf, Oacc[4 * db + d], 0, 0, 0);
                    __builtin_amdgcn_sched_barrier(0);
                }
#undef ATT_LDV
            }
        }
    }
#undef ATT_ISSUE
    const float l_tot = l_run + __shfl_xor(l_run, 32);
    lds_barrier();
    if (g == 1 && wave_on) { float* e = Ex + (size_t)wq * (NDT * 16 + 2) * 64;
#pragma unroll
        for (int d = 0; d < NDT; ++d)
#pragma unroll
            for (int i = 0; i < 16; ++i) e[(d * 16 + i) * 64 + lane] = Oacc[d][i];
        e[(NDT * 16) * 64 + lane] = m_run; e[(NDT * 16 + 1) * 64 + lane] = l_tot; }
    lds_barrier();
    if (g == 0 && wave_on) { const float* e = Ex + (size_t)wq * (NDT * 16 + 2) * 64;
        const float m1 = e[(NDT * 16) * 64 + lane], l1 = e[(NDT * 16 + 1) * 64 + lane];
        const float m = fmaxf(m_run, m1); const float a0 = exp2f(m_run - m), a1 = exp2f(m1 - m); const float inv = 1.f / (l_tot * a0 + l1 * a1);
        const int qi = 32 * wq + l31;
        bf16_t* op = SAMPLE ? (bf16_t*)(ws + WS_OLAT) + (size_t)(b * 16 + (qi & 15)) * 1024 + (qi >> 4) * 256 : (bf16_t*)(ws + WS_YC) + (size_t)(qb * 128 + qi) * 512 + h * 128;
#pragma unroll
        for (int d = 0; d < NDT; ++d)
#pragma unroll
            for (int i4 = 0; i4 < 4; ++i4) { float o[4];
#pragma unroll
                for (int k = 0; k < 4; ++k) o[k] = (Oacc[d][4 * i4 + k] * a0 + e[(d * 16 + 4 * i4 + k) * 64 + lane] * a1) * inv;
                u32x2 wv; wv.x = pk2(o[0], o[1]); wv.y = pk2(o[2], o[3]); *(u32x2*)(op + 32 * d + 8 * i4 + 4 * hh) = wv; }
    }
    lds_barrier();
}

DI void ffn_act(CP c, int l, int bid, int nb) {
    unsigned char* ws = c->ws; const bf16_t* UP = (const bf16_t*)(ws + WS_UP); bf16_t* ACT = (bf16_t*)(ws + WS_ACT);
    const float* cw = c->in[I_FCW] + (size_t)l * 3 * DFF; const float* cb = c->in[I_FCB] + (size_t)l * DFF;
    const int g = bid * 512 + get_tid(); const int ngroups = (nb * 512) / 352; const int rg = g / 352, cc = (g % 352) * 8;
    if (rg >= ngroups) return;
    const int rows_per = (MT + ngroups - 1) / ngroups; const int r0 = rg * rows_per; const int r1 = (r0 + rows_per < MT) ? r0 + rows_per : MT;
    float w0[8], w1[8], w2[8], bb[8], a0[8], a1[8];
#pragma unroll
    for (int j = 0; j < 8; ++j) { w0[j] = cw[cc + j]; w1[j] = cw[DFF + cc + j]; w2[j] = cw[2 * DFF + cc + j]; bb[j] = cb[cc + j]; a0[j] = 0.f; a1[j] = 0.f; }
    for (int r = r0; r < r1; ++r) {
        const bool samp = r >= MP; const int b = (r - MP) >> 4, t = samp ? (r - MP) & 15 : r;
        float a2[8], vv[8], o[8];
        unpack8(*(const u32x4*)(UP + (size_t)r * 5632 + cc), a2); unpack8(*(const u32x4*)(UP + (size_t)r * 5632 + DFF + cc), vv);
        if (r == r0 || (samp && t == 0)) {
            if (t >= 1) unpack8(*(const u32x4*)(UP + (size_t)(r - 1) * 5632 + cc), a1);
            else {
#pragma unroll
                for (int j = 0; j < 8; ++j) a1[j] = samp ? c->in[I_SFFN][((size_t)(l * 32 + b) * 2 + 1) * DFF + cc + j] : 0.f; }
            if (t >= 2) unpack8(*(const u32x4*)(UP + (size_t)(r - 2) * 5632 + cc), a0);
            else {
#pragma unroll
                for (int j = 0; j < 8; ++j) a0[j] = samp ? c->in[I_SFFN][((size_t)(l * 32 + b) * 2 + t) * DFF + cc + j] : 0.f; }
        }
#pragma unroll
        for (int j = 0; j < 8; ++j) { const float y = w0[j] * a0[j] + w1[j] * a1[j] + w2[j] * a2[j] + bb[j]; o[j] = silu(y) * vv[j]; a0[j] = a1[j]; a1[j] = a2[j]; }
        *(u32x4*)(ACT + (size_t)r * DFF + cc) = pack8(o);
        float* so = nullptr;
        if (!samp && r >= MP - 2) so = c->out + O_PFFN + ((size_t)l * 2 + (r - (MP - 2))) * DFF + cc;
        if (samp && t >= 14) so = c->out + O_SFFN + ((size_t)(l * 32 + b) * 2 + (t - 14)) * DFF + cc;
        if (so) {
#pragma unroll
            for (int j = 0; j < 8; ++j) so[j] = a2[j]; }
    }
}

#define XB_TMO      128
#define XB_XCNT(j)  (256  + 64 * (j))
#define XB_XSUB(j)  (1280 + 64 * (j))
#define XB_XGEN(j)  (2304 + 64 * (j))
#define XB_TOP      3328
#define XB_TOPGEN   3392
#define XB_SPIN_CAP (1u << 20)
DI unsigned xb_ld(unsigned* p) { return __hip_atomic_load(p, __ATOMIC_RELAXED, __HIP_MEMORY_SCOPE_AGENT); }
DI unsigned xb_add(unsigned* p, unsigned v) { return __hip_atomic_fetch_add(p, v, __ATOMIC_RELAXED, __HIP_MEMORY_SCOPE_AGENT); }
DI unsigned xb_xcc_id() { return (unsigned)__builtin_amdgcn_s_getreg((3 << 11) | 20) & 0xFu; }
#define XB_SPIN(cond, bar) do { unsigned _sp = 0; while (cond) { __builtin_amdgcn_s_sleep(1); \
    if ((++_sp & 255u) == 0u) { if (xb_ld(&(bar)[XB_TMO])) break; if (_sp > XB_SPIN_CAP) { atomicAdd(&(bar)[XB_TMO], 1u); break; } } } } while (0)
DI void xcd_barrier(unsigned* bar, unsigned x, volatile LAS unsigned* st, unsigned G) {
    asm volatile("s_waitcnt vmcnt(0)" ::: "memory");
    __syncthreads();
    if (get_tid() == 0) {
        __builtin_amdgcn_s_waitcnt(0);
        unsigned nloc = st[0], nx = st[1];
        if (nloc == 0u) {
            unsigned sum, cnt, mine, sp = 0u;
            for (;;) { sum = 0u; cnt = 0u; mine = 0u;
#pragma unroll
                for (unsigned j = 0; j < 16; ++j) { const unsigned cj = xb_ld(&bar[XB_XCNT(j)]); sum += cj; cnt += (cj > 0u) ? 1u : 0u; mine = (j == x) ? cj : mine; }
                if (sum == G) break;
                __builtin_amdgcn_s_sleep(1);
                if ((++sp & 255u) == 0u) { if (xb_ld(&bar[XB_TMO])) break; if (sp > XB_SPIN_CAP) { atomicAdd(&bar[XB_TMO], 1u); break; } } }
            nloc = mine > 0u ? mine : 1u; nx = cnt > 0u ? cnt : 1u; st[0] = nloc; st[1] = nx; }
        const unsigned old = xb_add(&bar[XB_XSUB(x)], 1u);
        const unsigned gen = old / nloc;
        if (old + 1u == (gen + 1u) * nloc) {
            __builtin_amdgcn_fence(__ATOMIC_RELEASE, "agent");
            asm volatile("s_waitcnt vmcnt(0)" ::: "memory");
            const unsigned og = xb_add(&bar[XB_TOP], 1u);
            const unsigned tg = og / nx;
            if (og + 1u == (tg + 1u) * nx) xb_add(&bar[XB_TOPGEN], 1u);
            else XB_SPIN(xb_ld(&bar[XB_TOPGEN]) == tg, bar);
            __builtin_amdgcn_fence(__ATOMIC_ACQUIRE, "agent");
            xb_add(&bar[XB_XGEN(x)], 1u);
            asm volatile("s_waitcnt vmcnt(0)" ::: "memory");
        } else {
            XB_SPIN(xb_ld(&bar[XB_XGEN(x)]) == gen, bar);
            __builtin_amdgcn_fence(__ATOMIC_ACQUIRE, "agent");
            asm volatile("s_waitcnt vmcnt(0)" ::: "memory");
        }
    }
    __syncthreads();
}

DI void grid_barrier(unsigned* ctr, unsigned target) {
    __syncthreads();
    if (get_tid() == 0) {
        __builtin_amdgcn_fence(__ATOMIC_RELEASE, "agent");
        asm volatile("s_waitcnt vmcnt(0) lgkmcnt(0)" ::: "memory");
        __hip_atomic_fetch_add(ctr, 1u, __ATOMIC_RELAXED, __HIP_MEMORY_SCOPE_AGENT);
        while (__hip_atomic_load(ctr, __ATOMIC_RELAXED, __HIP_MEMORY_SCOPE_AGENT) < target) __builtin_amdgcn_s_sleep(2);
        __builtin_amdgcn_fence(__ATOMIC_ACQUIRE, "agent");
        asm volatile("s_waitcnt vmcnt(0) lgkmcnt(0)" ::: "memory");
    }
    __syncthreads();
}

DI int gemm_job_count(int ph) {
    if (ph == 1) return 1;
    if (ph < 3) return 0;
    const int sub = (ph - 3) % NSUB;
    if (sub == 0) return 1; if (sub == 2) return 4; if (sub == 5) return 6; if (sub == 6) return 1; if (sub == 8) return 1; if (sub == 10) return 1;
    return 0;
}
DI GemmJob make_job(CP c, int ph, int j) {
    unsigned char* ws = c->ws; GemmJob J; J.split = 1 << 30; J.o2 = nullptr; J.ld2 = 0; J.f1 = nullptr; J.row0 = 0; J.flag = 0; J.cstart = 0;
    const float* MOD = (const float*)(ws + WS_MOD);
    if (ph == 1) { J.A = (const bf16_t*)(ws + WS_SC); J.Bt = (const bf16_t*)(ws + WS_WADA); J.M = 256; J.N = 12288; J.K = 1024; J.lda = 1024; J.ldb = 1024; J.mode = 0;
        J.o1 = (void*)(ws + WS_MOD); J.ld1 = 12288; J.f1 = c->in[I_BADA]; J.flag = 64; return J; }
    const int l = (ph - 3) / NSUB, sub = (ph - 3) % NSUB;
    if (sub == 0) { J.A = (const bf16_t*)(ws + WS_H); J.Bt = (const bf16_t*)(ws + WS_WIN); J.M = MT; J.N = NIN; J.K = 1024; J.lda = 1024; J.ldb = 1024; J.mode = 1;
        J.o1 = ws + WS_Z1; J.ld1 = NZ1; J.o2 = ws + WS_G; J.ld2 = NG; J.split = NZ1; }
    else if (sub == 2) {
        J.mode = 1;
        if (j == 0) { J.A = (const bf16_t*)(ws + WS_QN); J.Bt = (const bf16_t*)(ws + WS_WUQ); J.M = MT; J.N = 768; J.K = 384; J.lda = 384; J.ldb = 384; J.o1 = ws + WS_Q; J.ld1 = 768; }
        else if (j == 1) { J.A = (const bf16_t*)(ws + WS_LAT); J.Bt = (const bf16_t*)(ws + WS_WUK); J.M = MP; J.N = 512; J.K = 256; J.lda = 256; J.ldb = 256; J.o1 = ws + WS_KN; J.ld1 = 512; }
        else if (j == 2) { J.A = (const bf16_t*)(ws + WS_WUV); J.Bt = (const bf16_t*)(ws + WS_LAT); J.M = 512; J.N = MP; J.K = 256; J.lda = 256; J.ldb = 256; J.o1 = ws + WS_VT; J.ld1 = MP; }
        else { J.A = (const bf16_t*)(ws + WS_QN) + (size_t)MP * 384; J.Bt = (const bf16_t*)(ws + WS_WQABS); J.M = MS; J.N = 1024; J.K = 384; J.lda = 384; J.ldb = 384; J.o1 = ws + WS_QABS; J.ld1 = 1024; }
        J.cstart = (j == 0) ? 0 : (j == 1 ? 206 : (j == 2 ? 78 : 198));
    } else if (sub == 5) {
        const int i = j >> 1, sp = j & 1; const size_t r0 = sp ? MP : 0; J.mode = 2; J.M = sp ? MS : MP; J.N = 1024; J.flag = (i == 0);
        J.o1 = (bf16_t*)(ws + WS_MG) + r0 * 1024; J.ld1 = 1024; J.o2 = (bf16_t*)(ws + WS_G) + r0 * NG + i * 1024; J.ld2 = NG;
        if (i == 2 && sp) { J.A = (const bf16_t*)(ws + WS_OLAT); J.Bt = (const bf16_t*)(ws + WS_WBRC); J.K = 1024; J.lda = 1024; J.ldb = 1024; }
        else { J.A = (const bf16_t*)(ws + (i == 0 ? WS_YA : (i == 1 ? WS_YB : WS_YC))) + r0 * 512; J.Bt = (const bf16_t*)(ws + WS_WBR) + (size_t)i * 1024 * 512; J.K = 512; J.lda = 512; J.ldb = 512; }
    } else if (sub == 6) { J.A = (const bf16_t*)(ws + WS_MG); J.Bt = (const bf16_t*)(ws + WS_WOUT); J.M = MT; J.N = 1024; J.K = 1024; J.lda = 1024; J.ldb = 1024; J.mode = 3;
        J.o1 = ws + WS_XB; J.ld1 = 1024; J.f1 = MOD + l * 6144 + 2 * 1024; }
    else if (sub == 8) { J.A = (const bf16_t*)(ws + WS_H); J.Bt = (const bf16_t*)(ws + WS_WUP); J.M = MT; J.N = 5632; J.K = 1024; J.lda = 1024; J.ldb = 1024; J.mode = 1; J.o1 = ws + WS_UP; J.ld1 = 5632; }
    else { J.A = (const bf16_t*)(ws + WS_ACT); J.Bt = (const bf16_t*)(ws + WS_WDN); J.M = MT; J.N = 1024; J.K = DFF; J.lda = DFF; J.ldb = DFF; J.mode = 3;
        J.o1 = ws + WS_XB; J.ld1 = 1024; J.f1 = MOD + l * 6144 + 5 * 1024; }
    return J;
}

__global__ void __launch_bounds__(512) fwd_megakernel(Ctx carg) {
    extern __shared__ __attribute__((aligned(16))) unsigned char smem[];
    cg::grid_group grid = cg::this_grid();
    const int bid = blockIdx.x, nb = gridDim.x;
    CP c0 = (CP)__builtin_amdgcn_kernarg_segment_ptr();
    int nbar = 0;
    volatile LAS unsigned* xst = (volatile LAS unsigned*)((LAS unsigned char*)smem + LDS_MISC + 64);
    const unsigned xcc = xb_xcc_id();
    if (threadIdx.x == 0) { xst[0] = 0u; xst[1] = 0u; (void)xb_add((unsigned*)(carg.ws + WS_CTL) + XB_XCNT(xcc), 1u); }
    __syncthreads();
    for (int ph = carg.ph_lo; ph < carg.ph_hi; ++ph) {
      const int nrep = (PROBE_DUP >= 0 && ((PROBE_DUP == 100 && ph == 0) || (ph >= 3 && (ph - 3) % NSUB == PROBE_DUP))) ? 2 : 1;
      for (int rep = 0; rep < nrep; ++rep) {
        CP c = c0; asm volatile("" : "+s"(c));
        const int tid = get_tid(), lane = tid & 63, wave = tid >> 6;
        unsigned char* ws = c->ws; const float* MOD = (const float*)(ws + WS_MOD);
        const int njobs = gemm_job_count(ph);
        for (int j = 0; j < njobs; ++j) { const GemmJob J = make_job(c, ph, j); gemm_phase((LAS unsigned char*)smem, J, nb, (nb == 256) ? ((bid + 256 - J.cstart) & 255) : bid); }
        if (ph == 0) { convert_weights(c, 0, (float*)smem, bid, nb, 7); prep_once(c, (float*)smem, bid, nb); }
        else if (ph == 1) { ln_pass(c, 0, c->in[I_LN0G], c->in[I_LN0B], nullptr, nullptr, bid, nb, false); }
        else if (ph == 2) { ln_pass(c, 1, nullptr, nullptr, MOD + 1024, MOD, bid, nb, false); }
        else {
            const int l = (ph - 3) / NSUB, sub = (ph - 3) % NSUB;
            if (l == 0 && bid >= 8 && sub == 5) convert_weights(c, 1, (float*)smem, bid - 8, nb - 8, 1);
            if (l == 0 && bid >= 8 && sub == 10) convert_weights(c, 1, (float*)smem, bid - 8, nb - 8, 2);
            if (sub == 1) {
                for (int it = bid; it < NITEM_GDN; it += nb) gdn_chunk(c, l, it, (float*)smem);
                for (int it = (nb == 256) ? ((bid + 128) & 255) : bid; it < 544; it += nb) conva_tile(c, l, it, (float*)smem);
                for (int b = 0; b < 32; ++b) transpose_cvt(c->in[I_CLAT] + ((size_t)(l * 32 + b) * 2048) * 256, 2048, 256, 256, (bf16_t*)(ws + WS_LATT) + (size_t)b * 256 * LTS, LTS, (float*)smem, (bid + 8 * b) % nb, nb);
                for (int i = bid * 512 + tid; i < 32 * 256 * 6; i += nb * 512) { const int row = i / 6, s = i % 6; *(u32x4*)((bf16_t*)(ws + WS_LATT) + (size_t)row * LTS + 2064 + s * 8) = (u32x4){0u, 0u, 0u, 0u}; }
                for (int r = bid * 8 + wave; r < MT; r += nb * 8) mla_row(c, l, r, lane);
            } else if (sub == 3) {
                unsigned* qctr = (unsigned*)(ws + WS_CTL) + 16 + l + 2 * rep; volatile int* sitem = (volatile int*)(smem + LDS_MISC);
                if (bid < 12) gdn_scan(c, l, 0, bid & 3, 1 + (bid >> 2), smem);
                for (;;) {
                    lds_barrier();
                    if (tid == 0) *sitem = (int)atomicAdd(qctr, 1u);
                    lds_barrier();
                    const int it = *sitem;
                    if (it >= 128 + 32 + 512) break;
                    if (it < 128) gdn_scan(c, l, 1 + (it >> 2), it & 3, 0, smem);
                    else if (it < 160) attn_item<320, 256, 32, true>(c, l, it - 128, 0, smem);
                    else { const int k = it - 160; attn_item<192, 128, 64, false>(c, l, 127 - (k >> 2), k & 3, smem); }
                }
            } else if (sub == 4) { for (int it = bid; it < NITEM_GDN + 4; it += nb) gdn_out(c, l, it, smem); }
            else if (sub == 7) { ln_pass(c, 2, c->in[I_LN1G] + l * 1024, c->in[I_LN1B] + l * 1024, MOD + l * 6144 + 4 * 1024, MOD + l * 6144 + 3 * 1024, bid, nb, false); }
            else if (sub == 9) { ffn_act(c, l, bid, nb); }
            else if (sub == 11) {
                if (l == 0) { ln_pass(c, 2, c->in[I_LN2G], c->in[I_LN2B], MOD + 6144 + 1024, MOD + 6144, bid, nb, false); convert_weights(c, 1, (float*)smem, bid, nb, 4); }
                else ln_pass(c, 2, c->in[I_LN2G] + 1024, c->in[I_LN2B] + 1024, nullptr, nullptr, bid, nb, true);
            }
        }
        if (ph + 1 < carg.ph_hi || rep + 1 < nrep) {
            if (carg.ph_lo < 0) grid.sync();
            xcd_barrier((unsigned*)(ws + WS_CTL), xcc, xst, (unsigned)nb);
            ++nbar;
        }
      }
    }
}

extern "C" void kernel_launch(void* const* d_in, const int* in_sizes, int n_in, void* d_out, int out_size, void* d_ws, size_t ws_size, hipStream_t stream) {
    static int grid_blocks = 0;
    if (grid_blocks == 0) {
        if (n_in != N_IN || (size_t)out_size != O_END || ws_size < WS_END) { fprintf(stderr, "kernel_launch: unexpected shapes n_in %d out %d ws %zu (need %zu)\n", n_in, out_size, ws_size, (size_t)WS_END); grid_blocks = -1; return; }
        int dev = 0, cus = 0, per_cu = 0;
        hipGetDevice(&dev); hipDeviceGetAttribute(&cus, hipDeviceAttributeMultiprocessorCount, dev);
        if (hipFuncSetAttribute((const void*)fwd_megakernel, hipFuncAttributeMaxDynamicSharedMemorySize, LDS_BYTES) != hipSuccess) { fprintf(stderr, "kernel_launch: hipFuncSetAttribute failed\n"); grid_blocks = -1; return; }
        hipOccupancyMaxActiveBlocksPerMultiprocessor(&per_cu, (const void*)fwd_megakernel, 512, LDS_BYTES);
        (void)hipGetLastError();
        if (per_cu < 1) per_cu = 1;
        grid_blocks = cus;
    }
    if (grid_blocks < 0) return;
    hipMemsetAsync((char*)d_ws + WS_CTL, 0, WS_CTL_BYTES, stream);
    Ctx c{};
    for (int i = 0; i < N_IN; ++i) c.in[i] = (const float*)d_in[i];
    c.out = (float*)d_out; c.ws = (unsigned char*)d_ws; c.ph_lo = 0; c.ph_hi = NPHASE;
    void* args[] = {&c};
    hipError_t e = hipLaunchCooperativeKernel((const void*)fwd_megakernel, dim3(grid_blocks), dim3(512), args, LDS_BYTES, stream);
    if (e != hipSuccess) fprintf(stderr, "cooperative launch failed: %s (grid %d)\n", hipGetErrorString(e), grid_blocks);
}
```
